# Optimizing an MI355X kernel written in HIP

```python
import math
import jax, jax.numpy as jnp
from jax import lax
import numpy as np

D_MODEL = 1024
BATCH = 4
SEQ = 4096
DEPTH = 1

MIX_WIDTH = D_MODEL
FOURIER_WIDTH = MIX_WIDTH // 2
N_FOURIER_GROUPS = 4
FOURIER_GROUP = FOURIER_WIDTH // N_FOURIER_GROUPS
DIFF_WIDTH = MIX_WIDTH - FOURIER_WIDTH
N_DIFF_HEADS = 4
DIFF_VDIM = DIFF_WIDTH // N_DIFF_HEADS
DIFF_QKDIM = DIFF_VDIM // 2
IN_PROJ_WIDTH = FOURIER_WIDTH + 3 * DIFF_WIDTH
D_FF = 2816
CONV_WIDTH = 3
NUM_BUCKETS = 32
MAX_DISTANCE = 128
Q_BLOCK = 128
EPS = 1e-6

kernel_name = "hybrid_fourier_diffattn_convffn_encoder"


def rms_norm(x, g):
    xf = x.astype(jnp.float32)
    y = xf * lax.rsqrt(jnp.mean(xf * xf, axis=-1, keepdims=True) + EPS)
    return (y * g.astype(jnp.float32)).astype(x.dtype)


def t5_bucket(rel):
    half = NUM_BUCKETS // 2
    max_exact = half // 2
    ret = (rel > 0).astype(jnp.int32) * half
    n = jnp.abs(rel)
    nf = jnp.maximum(n, 1).astype(jnp.float32)
    large = max_exact + (jnp.log(nf / max_exact) / math.log(MAX_DISTANCE / max_exact)
                         * (half - max_exact)).astype(jnp.int32)
    large = jnp.minimum(large, half - 1)
    return ret + jnp.where(n < max_exact, n, large)


def fourier_mixer(u, w, b):
    B, S, _ = u.shape
    ug = u.reshape(B, S, N_FOURIER_GROUPS, FOURIER_GROUP).astype(jnp.float32)
    f = jnp.fft.fftn(ug, axes=(1, 3), norm="ortho").real
    y = jnp.einsum('bsgc,gcd->bsgd', f, w.astype(jnp.float32)) + b.astype(jnp.float32)
    return y.reshape(B, S, FOURIER_WIDTH).astype(u.dtype)


def diff_attention(q, k, v, lam, rel_bias, subln_g, lambda_init):
    B, S = q.shape[0], q.shape[1]
    nb = S // Q_BLOCK
    scale = DIFF_QKDIM ** -0.5
    qb = jnp.moveaxis(q.reshape(B, nb, Q_BLOCK, N_DIFF_HEADS, 2, DIFF_QKDIM), 1, 0)
    starts = jnp.arange(nb, dtype=jnp.int32) * Q_BLOCK
    kpos = jnp.arange(S, dtype=jnp.int32)

    def block(args):
        qblk, start = args
        qpos = start + jnp.arange(Q_BLOCK, dtype=jnp.int32)
        bucket = t5_bucket(kpos[None, :] - qpos[:, None])
        bias = jnp.moveaxis(rel_bias[bucket].astype(jnp.float32), -1, 0)
        logits = jnp.einsum('bqhmd,bkhmd->bhmqk', qblk, k,
                            preferred_element_type=jnp.float32) * scale
        logits = logits + bias[None, :, None]
        p = jax.nn.softmax(logits, axis=-1)
        a = p[:, :, 0] - lam * p[:, :, 1]
        return jnp.einsum('bhqk,bkhe->bqhe', a.astype(v.dtype), v)

    o = lax.map(block, (qb, starts))
    o = jnp.moveaxis(o, 0, 1).reshape(B, S, N_DIFF_HEADS, DIFF_VDIM)
    o = rms_norm(o, subln_g) * (1.0 - lambda_init)
    return o.reshape(B, S, DIFF_WIDTH)


def conv_ffn(h, w_up, conv_w, conv_b, w_down):
    S = h.shape[1]
    u = h @ w_up
    up = jnp.pad(u, ((0, 0), (1, 1), (0, 0)))
    c = (conv_w[0] * up[:, 0:S] + conv_w[1] * up[:, 1:S + 1]
         + conv_w[2] * up[:, 2:S + 2] + conv_b)
    gate, val = jnp.split(c, 2, axis=-1)
    return (jax.nn.silu(gate) * val) @ w_down


def setup_inputs(seed: int = 0) -> dict:
    key = jax.random.key(seed)
    ks = jax.random.split(key, 20)
    f32 = jnp.float32
    nrm = lambda k, shape, s: jax.random.normal(k, shape, f32) * s
    return {
        "x": nrm(ks[0], (BATCH, SEQ, D_MODEL), 1.0),
        "norm_mix_g": 1.0 + nrm(ks[1], (DEPTH, D_MODEL), 0.01),
        "w_in": nrm(ks[2], (DEPTH, D_MODEL, IN_PROJ_WIDTH), D_MODEL ** -0.5),
        "fourier_w": nrm(ks[3], (DEPTH, N_FOURIER_GROUPS, FOURIER_GROUP, FOURIER_GROUP), FOURIER_GROUP ** -0.5),
        "fourier_b": nrm(ks[4], (DEPTH, N_FOURIER_GROUPS, FOURIER_GROUP), 0.01),
        "lambda_q1": nrm(ks[5], (DEPTH, DIFF_QKDIM), 0.1),
        "lambda_k1": nrm(ks[6], (DEPTH, DIFF_QKDIM), 0.1),
        "lambda_q2": nrm(ks[7], (DEPTH, DIFF_QKDIM), 0.1),
        "lambda_k2": nrm(ks[8], (DEPTH, DIFF_QKDIM), 0.1),
        "subln_g": 1.0 + nrm(ks[9], (DEPTH, DIFF_VDIM), 0.01),
        "rel_bias": nrm(ks[10], (NUM_BUCKETS, N_DIFF_HEADS), 0.5),
        "w_out": nrm(ks[11], (DEPTH, MIX_WIDTH, D_MODEL), MIX_WIDTH ** -0.5),
        "norm_ffn_g": 1.0 + nrm(ks[12], (DEPTH, D_MODEL), 0.01),
        "w_up": nrm(ks[13], (DEPTH, D_MODEL, 2 * D_FF), D_MODEL ** -0.5),
        "conv_w": nrm(ks[14], (DEPTH, CONV_WIDTH, 2 * D_FF), CONV_WIDTH ** -0.5),
        "conv_b": nrm(ks[15], (DEPTH, 2 * D_FF), 0.01),
        "w_down": nrm(ks[16], (DEPTH, D_FF, D_MODEL), D_FF ** -0.5),
        "norm_final_g": 1.0 + nrm(ks[17], (D_MODEL,), 0.01),
    }


def reference(x, norm_mix_g, w_in, fourier_w, fourier_b, lambda_q1, lambda_k1,
              lambda_q2, lambda_k2, subln_g, rel_bias, w_out, norm_ffn_g, w_up,
              conv_w, conv_b, w_down, norm_final_g):
    B, S, _ = x.shape
    for l in range(DEPTH):
        lambda_init = 0.8 - 0.6 * math.exp(-0.3 * l)
        h = rms_norm(x, norm_mix_g[l])
        p = h @ w_in[l]
        pf = p[..., :FOURIER_WIDTH]
        pq = p[..., FOURIER_WIDTH:FOURIER_WIDTH + DIFF_WIDTH]
        pk = p[..., FOURIER_WIDTH + DIFF_WIDTH:FOURIER_WIDTH + 2 * DIFF_WIDTH]
        pv = p[..., FOURIER_WIDTH + 2 * DIFF_WIDTH:]
        y_f = fourier_mixer(pf, fourier_w[l], fourier_b[l])
        q = pq.reshape(B, S, N_DIFF_HEADS, 2, DIFF_QKDIM)
        k = pk.reshape(B, S, N_DIFF_HEADS, 2, DIFF_QKDIM)
        v = pv.reshape(B, S, N_DIFF_HEADS, DIFF_VDIM)
        lam = (jnp.exp(jnp.sum(lambda_q1[l].astype(jnp.float32) * lambda_k1[l].astype(jnp.float32)))
               - jnp.exp(jnp.sum(lambda_q2[l].astype(jnp.float32) * lambda_k2[l].astype(jnp.float32)))
               + lambda_init)
        y_a = diff_attention(q, k, v, lam, rel_bias, subln_g[l], lambda_init)
        x = x + jnp.concatenate([y_f, y_a], axis=-1) @ w_out[l]
        x = x + conv_ffn(rms_norm(x, norm_ffn_g[l]), w_up[l], conv_w[l], conv_b[l], w_down[l])
    return rms_norm(x, norm_final_g)
```

```cpp
#include <hip/hip_runtime.h>
#include <hip/hip_bf16.h>
#include <cstdio>
#include <cstdint>

#ifndef MK_N_LAUNCHES
#define MK_N_LAUNCHES 1
#endif
constexpr int N_PHASES = 10;

constexpr int D = 1024, BATCH = 4, SEQ = 4096, M = BATCH * SEQ, FW = 512, NH = 4, DFF = 2816, NUP = 2 * DFF;
constexpr float EPS = 1e-6f, LOG2E = 1.4426950408889634f;

namespace pg8 {
#define PG8_LAS __attribute__((address_space(3)))
typedef unsigned short bf16_t;
typedef short bf16x8 __attribute__((ext_vector_type(8)));
typedef float f32x4 __attribute__((ext_vector_type(4)));
typedef unsigned u32x4 __attribute__((ext_vector_type(4)));
typedef unsigned u32x2 __attribute__((ext_vector_type(2)));
constexpr int BM = 256, BK = 64, HALF = 128, HTB = HALF * BK * 2, STAGE_BYTES = 8 * HTB, NXCD = 8, WGM = 8;

__host__ __device__ __forceinline__ int lds_byte(int r, int c) { const int st = (r >> 4) * 2 + (c >> 5), rr = r & 15, cc = c & 31, ob = rr * 64 + cc * 2; return st * 1024 + (ob ^ (((ob >> 9) & 1) << 5)); }
__host__ __device__ __forceinline__ void stage_rc(int b, int& R, int& C) { const int st = b / 1024, sb = b % 1024, swz = sb ^ (((sb >> 9) & 1) << 5); R = (st >> 1) * 16 + swz / 64; C = (st & 1) * 32 + (swz % 64) / 2; }
__host__ __device__ __forceinline__ int perm32(int rho) { const int n = rho >> 4, i = rho & 15; return 8 * (i >> 2) + 4 * n + (i & 3); }

struct Unit { int pm, pn; };
struct Gemm { const bf16_t* A; const bf16_t* Bt; int K; size_t tstepA, hstepA, tstepB, hstepB; };

struct StaticOrder {
    int nM, nN, nwg, G, c;
    __host__ __device__ void init(int nM_, int nN_, int G_, int c_) { nM = nM_; nN = nN_; nwg = nM * nN; G = G_; c = c_; }
    __host__ __device__ bool next(int i, Unit& u) const {
        const long L = (long)i * G + c; if (L >= nwg) return false;
        int wgid = (int)L; { const int q = nwg / NXCD, r = nwg % NXCD, xcd = wgid % NXCD, off = wgid / NXCD; wgid = (xcd < r ? xcd * (q + 1) : r * (q + 1) + (xcd - r) * q) + off; }
        const int nig = WGM * nN, gid = wgid / nig, fm = gid * WGM, gsz = (nM - fm) < WGM ? (nM - fm) : WGM;
        u.pm = fm + ((wgid % nig) % gsz); u.pn = (wgid % nig) / gsz; return true;
    }
};

__device__ __forceinline__ unsigned cvt_pk_bf16(float lo, float hi) { unsigned r; asm volatile("v_cvt_pk_bf16_f32 %0, %1, %2" : "=v"(r) : "v"(lo), "v"(hi)); return r; }


struct EpiQKV {
    static constexpr bool PERM = true, NEEDS_SYNC = false;
    bf16_t* O; size_t split_stride; float scale0;
    __device__ __forceinline__ void operator()(const f32x4 (&acc)[2][2][4][2], const Unit& u, int wr, int wc, int fr, int fq) const {
        const int row0 = u.pm * BM + wr * 64 + fr; int colt = u.pn * BM; bf16_t* base = O;
        const int t = colt / 512; base += (size_t)t * split_stride; colt -= t * 512; const float sc = (t == 0) ? scale0 : 1.f;
        const int col0 = colt + wc * 32 + 8 * fq;
#pragma unroll
        for (int ai = 0; ai < 2; ++ai)
#pragma unroll
            for (int m = 0; m < 4; ++m) { bf16_t* rowp = base + (size_t)(row0 + ai * HALF + m * 16) * 512 + col0;
#pragma unroll
                for (int bj = 0; bj < 2; ++bj) { f32x4 v0 = acc[ai][bj][m][0] * sc, v1 = acc[ai][bj][m][1] * sc;
                    u32x4 w; w.x = cvt_pk_bf16(v0[0], v0[1]); w.y = cvt_pk_bf16(v0[2], v0[3]); w.z = cvt_pk_bf16(v1[0], v1[1]); w.w = cvt_pk_bf16(v1[2], v1[3]);
                    *(u32x4*)(rowp + bj * HALF) = w; } }
    }
};
struct EpiUT {
    static constexpr bool PERM = true, NEEDS_SYNC = false;
    bf16_t* UT;
    __device__ __forceinline__ void operator()(const f32x4 (&acc)[2][2][4][2], const Unit& u, int wr, int wc, int fr, int fq) const {
        const int b = u.pn >> 4, s0 = (u.pn & 15) * 256 + wc * 32 + 8 * fq;
#pragma unroll
        for (int ai = 0; ai < 2; ++ai)
#pragma unroll
            for (int m = 0; m < 4; ++m) { const int r = u.pm * BM + ai * HALF + wr * 64 + m * 16 + fr; const int part = r >> 9, d = r & 511;
                bf16_t* rowp = UT + ((size_t)(b * 512 + d) * 8192 + part * 4096 + s0);
#pragma unroll
                for (int bj = 0; bj < 2; ++bj) { const f32x4 v0 = acc[ai][bj][m][0], v1 = acc[ai][bj][m][1];
                    u32x4 w; w.x = cvt_pk_bf16(v0[0], v0[1]); w.y = cvt_pk_bf16(v0[2], v0[3]); w.z = cvt_pk_bf16(v1[0], v1[1]); w.w = cvt_pk_bf16(v1[2], v1[3]);
                    *(u32x4*)(rowp + bj * HALF) = w; } }
    }
};
struct EpiDFT {
    static constexpr bool PERM = true, NEEDS_SYNC = false;
    bf16_t* YC; const float* fb;
    __device__ __forceinline__ void operator()(const f32x4 (&acc)[2][2][4][2], const Unit& u, int wr, int wc, int fr, int fq) const {
        const int b = u.pn >> 1, d0 = (u.pn & 1) * 256 + wc * 32 + 8 * fq;
        f32x4 bv[2][2];
#pragma unroll
        for (int bj = 0; bj < 2; ++bj)
#pragma unroll
            for (int n = 0; n < 2; ++n) bv[bj][n] = *(const f32x4*)(fb + d0 + bj * HALF + 4 * n);
#pragma unroll
        for (int ai = 0; ai < 2; ++ai)
#pragma unroll
            for (int m = 0; m < 4; ++m) { const int sp = u.pm * BM + ai * HALF + wr * 64 + m * 16 + fr;
                bf16_t* rowp = YC + ((size_t)(b * 4096 + sp) * 1024 + d0);
#pragma unroll
                for (int bj = 0; bj < 2; ++bj) { const f32x4 v0 = acc[ai][bj][m][0] + bv[bj][0], v1 = acc[ai][bj][m][1] + bv[bj][1];
                    u32x4 w; w.x = cvt_pk_bf16(v0[0], v0[1]); w.y = cvt_pk_bf16(v0[2], v0[3]); w.z = cvt_pk_bf16(v1[0], v1[1]); w.w = cvt_pk_bf16(v1[2], v1[3]);
                    *(u32x4*)(rowp + bj * HALF) = w; } }
    }
};
struct EpiResF32 {
    static constexpr bool PERM = false, NEEDS_SYNC = false;
    const float* base; float* out;
    __device__ __forceinline__ void operator()(const f32x4 (&acc)[2][2][4][2], const Unit& u, int wr, int wc, int fr, int fq) const {
        const int row0 = u.pm * BM + wr * 64 + fr, col0 = u.pn * BM + wc * 32 + 4 * fq;
#pragma unroll
        for (int ai = 0; ai < 2; ++ai)
#pragma unroll
            for (int m = 0; m < 4; ++m) { const size_t off = (size_t)(row0 + ai * HALF + m * 16) * 1024 + col0;
#pragma unroll
                for (int bj = 0; bj < 2; ++bj)
#pragma unroll
                    for (int n = 0; n < 2; ++n) { const f32x4 bs = *(const f32x4*)(base + off + bj * HALF + n * 16); *(f32x4*)(out + off + bj * HALF + n * 16) = bs + acc[ai][bj][m][n]; } }
    }
};

__device__ __forceinline__ float dpp_shr1(float old, float src) { return __builtin_bit_cast(float, __builtin_amdgcn_update_dpp(__builtin_bit_cast(int, old), __builtin_bit_cast(int, src), 0x111, 0xf, 0xf, false)); }
__device__ __forceinline__ float dpp_shl1(float old, float src) { return __builtin_bit_cast(float, __builtin_amdgcn_update_dpp(__builtin_bit_cast(int, old), __builtin_bit_cast(int, src), 0x101, 0xf, 0xf, false)); }
__device__ __forceinline__ float dpp_ror1(float src) { return __builtin_bit_cast(float, __builtin_amdgcn_update_dpp(0, __builtin_bit_cast(int, src), 0x121, 0xf, 0xf, false)); }
__device__ __forceinline__ float dpp_rol1(float src) { return __builtin_bit_cast(float, __builtin_amdgcn_update_dpp(0, __builtin_bit_cast(int, src), 0x12F, 0xf, 0xf, false)); }

struct EpiConvAct {
    static constexpr bool PERM = true, NEEDS_SYNC = true;
    bf16_t* ACT; const float* conv_w; const float* conv_b; PG8_LAS float* xch;
    __device__ __forceinline__ void operator()(const f32x4 (&acc)[2][2][4][2], const Unit& u, int wr, int wc, int fr, int fq) const {
        const int tc0 = wc * 32 + 8 * fq;
#pragma unroll
        for (int ai = 0; ai < 2; ++ai) { const int ch = 2 * ai + wr;
#pragma unroll
            for (int bj = 0; bj < 2; ++bj)
#pragma unroll
                for (int n = 0; n < 2; ++n) {
                    if (fr == 0)  *(PG8_LAS f32x4*)(xch + (ch * 2 + 0) * 256 + bj * HALF + tc0 + 4 * n) = acc[ai][bj][0][n];
                    if (fr == 15) *(PG8_LAS f32x4*)(xch + (ch * 2 + 1) * 256 + bj * HALF + tc0 + 4 * n) = acc[ai][bj][3][n]; } }
        asm volatile("s_waitcnt lgkmcnt(0)" ::: "memory"); __builtin_amdgcn_s_barrier(); asm volatile("" ::: "memory");
        const int jg = u.pn * HALF + tc0;
#pragma unroll
        for (int n = 0; n < 2; ++n) {
            f32x4 w0[2], w1[2], w2[2], cb[2];
#pragma unroll
            for (int bj = 0; bj < 2; ++bj) { const int ch = bj * DFF + jg + 4 * n;
                w0[bj] = *(const f32x4*)(conv_w + ch); w1[bj] = *(const f32x4*)(conv_w + NUP + ch); w2[bj] = *(const f32x4*)(conv_w + 2 * NUP + ch); cb[bj] = *(const f32x4*)(conv_b + ch); }
#pragma unroll
            for (int ai = 0; ai < 2; ++ai) { const int ch = 2 * ai + wr;
                f32x4 xup[2], xdn[2];
#pragma unroll
                for (int bj = 0; bj < 2; ++bj) {
                    xup[bj] = *(const PG8_LAS f32x4*)(xch + (((ch + 3) & 3) * 2 + 1) * 256 + bj * HALF + tc0 + 4 * n);
                    xdn[bj] = *(const PG8_LAS f32x4*)(xch + (((ch + 1) & 3) * 2 + 0) * 256 + bj * HALF + tc0 + 4 * n); }
#pragma unroll
                for (int m = 0; m < 4; ++m) {
                    const int tr = ai * HALF + wr * 64 + m * 16 + fr; const int g = u.pm * 254 - 1 + tr;
                    const bool has_up = (g & 4095) != 0, has_dn = (g & 4095) != 4095;
                    float cv[2][4];
#pragma unroll
                    for (int bj = 0; bj < 2; ++bj)
#pragma unroll
                        for (int e = 0; e < 4; ++e) {
                            const float cur = acc[ai][bj][m][n][e];
                            float up, dn;
                            if (m == 0) up = dpp_shr1(xup[bj][e], cur); else up = dpp_shr1(dpp_ror1(acc[ai][bj][m - 1][n][e]), cur);
                            if (m == 3) dn = dpp_shl1(xdn[bj][e], cur); else dn = dpp_shl1(dpp_rol1(acc[ai][bj][m + 1][n][e]), cur);
                            up = has_up ? up : 0.f; dn = has_dn ? dn : 0.f;
                            cv[bj][e] = w0[bj][e] * up + (w1[bj][e] * cur + (w2[bj][e] * dn + cb[bj][e]));
                        }
                    float a[4];
#pragma unroll
                    for (int e = 0; e < 4; ++e) { const float gt = cv[0][e]; const float sg = __builtin_amdgcn_rcpf(1.f + __builtin_amdgcn_exp2f(-LOG2E * gt)); a[e] = gt * sg * cv[1][e]; }
                    u32x2 w; w.x = cvt_pk_bf16(a[0], a[1]); w.y = cvt_pk_bf16(a[2], a[3]);
                    if (tr >= 1 && tr <= 254 && g < M) *(u32x2*)(ACT + (size_t)g * DFF + jg + 4 * n) = w;
                }
            }
        }
        asm volatile("s_waitcnt lgkmcnt(0)" ::: "memory"); __builtin_amdgcn_s_barrier(); asm volatile("" ::: "memory");
    }
};

template <class Epi, class Sched>
__device__ __forceinline__ void gemm_phase(PG8_LAS unsigned char* lds, const Gemm g, const Sched& S, const Epi& E) {
    const int tid = threadIdx.x, wid = __builtin_amdgcn_readfirstlane(tid >> 6), lane = tid & 63, wr = wid >> 2, wc = wid & 3, fr = lane & 15, fq = lane >> 4;
    const int K = g.K, nt = K / BK;
    unsigned voffA[2], voffB[2];
#pragma unroll
    for (int i = 0; i < 2; ++i) { int R, C; stage_rc(tid * 16 + i * 8192, R, C); const int Rb = Epi::PERM ? ((R & ~31) + perm32(R & 31)) : R;
        voffA[i] = (unsigned)(R * K + C) * 2u; voffB[i] = (unsigned)(Rb * K + C) * 2u; }
    const size_t kstep = (size_t)(BK * 2);
    const size_t hsA = g.hstepA, hsB = g.hstepB;
    const unsigned ldsw = (unsigned)wid * 1024u;
    const int aoff = lds_byte(wr * 64 + fr, fq * 8), boff = lds_byte(wc * 32 + fr, fq * 8);
#define PG8_SA(b, h) (((b) * 2 + (h)) * HTB)
#define PG8_SB(b, h) ((4 + (b) * 2 + (h)) * HTB)
#define PG8_STAGE(bufoff, gbase, voff) do { _Pragma("unroll") for (int _i = 0; _i < 2; ++_i) \
        __builtin_amdgcn_global_load_lds((const unsigned*)((const char*)(gbase) + (voff)[_i]), (PG8_LAS unsigned*)(lds + (bufoff) + ldsw + _i * 8192), 16, 0, 0); } while (0)
#define PG8_LDA(dst, b, h) do { _Pragma("unroll") for (int m = 0; m < 4; ++m) _Pragma("unroll") for (int k = 0; k < 2; ++k) dst[m][k] = *(const PG8_LAS bf16x8*)(lds + PG8_SA(b, h) + aoff + m * 2048 + k * 1024); } while (0)
#define PG8_LDB(dst, b, h) do { _Pragma("unroll") for (int n = 0; n < 2; ++n) _Pragma("unroll") for (int k = 0; k < 2; ++k) dst[n][k] = *(const PG8_LAS bf16x8*)(lds + PG8_SB(b, h) + boff + n * 2048 + k * 1024); } while (0)
#define PG8_MMA(ai, bj, At, Bt) do { __builtin_amdgcn_s_setprio(1); _Pragma("unroll") for (int m = 0; m < 4; ++m) _Pragma("unroll") for (int n = 0; n < 2; ++n) _Pragma("unroll") for (int k = 0; k < 2; ++k) \
        acc[ai][bj][m][n] = __builtin_amdgcn_mfma_f32_16x16x32_bf16(Bt[n][k], At[m][k], acc[ai][bj][m][n], 0, 0, 0); __builtin_amdgcn_s_setprio(0); } while (0)
#define PG8_WAIT_V(n) asm volatile("s_waitcnt vmcnt(" #n ")" ::: "memory")
#define PG8_WAIT_L(n) asm volatile("s_waitcnt lgkmcnt(" #n ")" ::: "memory")
#define PG8_BAR __builtin_amdgcn_s_barrier()
#define PG8_SCHED __builtin_amdgcn_sched_barrier(0)
    Unit cur, nxt; int ui = 0;
    if (!S.next(0, cur)) return;
    f32x4 acc[2][2][4][2];
#pragma unroll
    for (int a = 0; a < 2; ++a)
#pragma unroll
        for (int b = 0; b < 2; ++b)
#pragma unroll
            for (int m = 0; m < 4; ++m)
#pragma unroll
                for (int n = 0; n < 2; ++n) acc[a][b][m][n] = (f32x4){0.f, 0.f, 0.f, 0.f};
    bf16x8 At[4][2], B0[2][2], B1[2][2];
    const char* cA = (const char*)g.A + (size_t)cur.pm * g.tstepA; const char* cB = (const char*)g.Bt + (size_t)cur.pn * g.tstepB;
    PG8_STAGE(PG8_SB(0, 0), cB, voffB); PG8_STAGE(PG8_SB(0, 1), cB + hsB, voffB); PG8_STAGE(PG8_SA(0, 0), cA, voffA); PG8_STAGE(PG8_SA(0, 1), cA + hsA, voffA);
    if (wr == 1) PG8_BAR;
    PG8_WAIT_V(2); PG8_BAR;
    PG8_STAGE(PG8_SB(1, 0), cB + kstep, voffB); PG8_STAGE(PG8_SA(1, 0), cA + kstep, voffA); PG8_STAGE(PG8_SB(1, 1), cB + hsB + kstep, voffB);
    PG8_WAIT_V(6); PG8_BAR;
    for (;;) {
        const bool has_next = S.next(ui + 1, nxt);
        const char* nA = has_next ? (const char*)g.A + (size_t)nxt.pm * g.tstepA : cA; const char* nB = has_next ? (const char*)g.Bt + (size_t)nxt.pn * g.tstepB : cB;
        for (int t = 0; t < nt; t += 2) {
            const bool last = (t == nt - 2);
            const char* a1 = cA + (size_t)(t + 1) * kstep;
            const char* a2 = last ? nA : cA + (size_t)(t + 2) * kstep; const char* b2 = last ? nB : cB + (size_t)(t + 2) * kstep;
            const char* a3 = a2 + kstep; const char* b3 = b2 + kstep;
            PG8_LDB(B0, 0, 0); PG8_LDB(B1, 0, 1); PG8_SCHED; PG8_LDA(At, 0, 0); PG8_STAGE(PG8_SA(1, 1), a1 + hsA, voffA);
            PG8_WAIT_V(8); PG8_WAIT_L(0); PG8_BAR; PG8_MMA(0, 0, At, B0); PG8_MMA(0, 1, At, B1); PG8_BAR; PG8_SCHED;
            PG8_LDA(At, 0, 1); PG8_STAGE(PG8_SB(0, 0), b2, voffB); PG8_STAGE(PG8_SB(0, 1), b2 + hsB, voffB); PG8_STAGE(PG8_SA(0, 0), a2, voffA);
            PG8_WAIT_V(8); PG8_WAIT_L(0); PG8_BAR; PG8_MMA(1, 0, At, B0); PG8_MMA(1, 1, At, B1); PG8_BAR; PG8_SCHED;
            PG8_LDB(B0, 1, 0); PG8_LDB(B1, 1, 1); PG8_SCHED; PG8_LDA(At, 1, 0); PG8_STAGE(PG8_SA(0, 1), a2 + hsA, voffA);
            PG8_WAIT_V(8); PG8_WAIT_L(0); PG8_BAR; PG8_MMA(0, 0, At, B0); PG8_MMA(0, 1, At, B1); PG8_BAR; PG8_SCHED;
            PG8_LDA(At, 1, 1); PG8_STAGE(PG8_SB(1, 0), b3, voffB); PG8_STAGE(PG8_SB(1, 1), b3 + hsB, voffB); PG8_STAGE(PG8_SA(1, 0), a3, voffA);
            PG8_WAIT_V(8); PG8_WAIT_L(0); PG8_BAR; PG8_MMA(1, 0, At, B0); PG8_MMA(1, 1, At, B1); PG8_BAR; PG8_SCHED;
        }
        if (wr == 0) PG8_BAR;
        E(acc, cur, wr, wc, fr, fq);
        if (!has_next) break;
#pragma unroll
        for (int a = 0; a < 2; ++a)
#pragma unroll
            for (int b = 0; b < 2; ++b)
#pragma unroll
                for (int m = 0; m < 4; ++m)
#pragma unroll
                    for (int n = 0; n < 2; ++n) acc[a][b][m][n] = (f32x4){0.f, 0.f, 0.f, 0.f};
        cur = nxt; cA = nA; cB = nB; ++ui;
        if (wr == 1) PG8_BAR;
    }
    PG8_WAIT_V(0);
    PG8_BAR;
#undef PG8_SA
#undef PG8_SB
#undef PG8_STAGE
#undef PG8_LDA
#undef PG8_LDB
#undef PG8_MMA
#undef PG8_WAIT_V
#undef PG8_WAIT_L
#undef PG8_BAR
#undef PG8_SCHED
}
}

namespace att {
using bf16 = __hip_bfloat16;
using bf16x8 = __attribute__((ext_vector_type(8))) short;
using s16x4  = __attribute__((ext_vector_type(4))) short;
using f32x16 = __attribute__((ext_vector_type(16))) float;
using f32x4  = __attribute__((ext_vector_type(4))) float;
using u32x4  = __attribute__((ext_vector_type(4))) unsigned;
constexpr int NW = 8, QBLK = 32, KVBLK = 64, LDK = 512;
constexpr size_t SHM_V = KVBLK * 128 * 2, SHM_K = KVBLK * 128 * 2;
constexpr int OFF_V = 0, OFF_K = 2 * (int)SHM_V, OFF_WS = OFF_K + 2 * (int)SHM_K, OFF_TB = OFF_WS + NW * 64 * 4, OFF_X = OFF_TB + 2304, XS = 132, X_FLOATS = 32 * XS;
constexpr int LDS_BYTES = OFF_X + 4 * X_FLOATS * 4;
constexpr float THRL = 8.f * LOG2E;
#define KSWZ(row, colB) ((row) * 256 + ((colB) ^ (((row) & 7) << 4)))
#define SBAR() __builtin_amdgcn_sched_barrier(0)
__device__ __forceinline__ int crow(int r, int hi) { return (r & 3) + 8 * (r >> 2) + 4 * hi; }
__device__ __forceinline__ unsigned cvtpk(float lo, float hi) { unsigned r; asm volatile("v_cvt_pk_bf16_f32 %0, %1, %2" : "=v"(r) : "v"(lo), "v"(hi)); return r; }
__device__ __forceinline__ int t5_bucket(int rel) {
    const int n = rel < 0 ? -rel : rel; int v;
    if (n < 8) v = n; else if (n < 12) v = 8; else if (n < 16) v = 9; else if (n < 23) v = 10; else if (n < 32) v = 11; else if (n < 46) v = 12; else if (n < 64) v = 13; else if (n < 91) v = 14; else v = 15;
    return (rel > 0 ? 16 : 0) + v;
}
__device__ __forceinline__ void partialSM(f32x16& p0, f32x16& p1, float& m_reg, float& mn, float& alpha) {
  float pmax = p0[0];
#pragma unroll
  for (int r = 1; r < 16; ++r) pmax = fmaxf(pmax, p0[r]);
#pragma unroll
  for (int r = 0; r < 16; ++r) pmax = fmaxf(pmax, p1[r]);
  { auto rr = __builtin_amdgcn_permlane32_swap(__float_as_uint(pmax), __float_as_uint(pmax), false, false);
    pmax = fmaxf(__uint_as_float(rr[0]), __uint_as_float(rr[1])); }
  if (__builtin_expect(__all(pmax - m_reg <= THRL), 1)) { mn = m_reg; alpha = 1.f; }
  else { mn = fmaxf(m_reg, pmax); alpha = __builtin_amdgcn_exp2f(m_reg - mn); m_reg = mn; }
#pragma unroll
  for (int r = 0; r < 16; ++r) p0[r] = p0[r] - mn;
#pragma unroll
  for (int r = 0; r < 16; ++r) p1[r] = p1[r] - mn;
#pragma unroll
  for (int r = 0; r < 16; ++r) p0[r] = __builtin_amdgcn_exp2f(p0[r]);
}
__device__ __forceinline__ void finishSM(f32x16& p0, f32x16& p1, float alpha, float& l_reg, bf16x8& pa0, bf16x8& pa1, bf16x8& pa2, bf16x8& pa3) {
#pragma unroll
  for (int r = 0; r < 16; ++r) p1[r] = __builtin_amdgcn_exp2f(p1[r]);
  float ps = 0;
#pragma unroll
  for (int r = 0; r < 16; ++r) ps += p0[r];
#pragma unroll
  for (int r = 0; r < 16; ++r) ps += p1[r];
  { auto rr = __builtin_amdgcn_permlane32_swap(__float_as_uint(ps), __float_as_uint(ps), false, false);
    ps = __uint_as_float(rr[0]) + __uint_as_float(rr[1]); }
  l_reg = l_reg * alpha + ps;
#define PK4(P, BASE, OUT) do { unsigned a0 = cvtpk(P[BASE + 0], P[BASE + 1]), a1 = cvtpk(P[BASE + 2], P[BASE + 3]);   \
    unsigned b0 = cvtpk(P[BASE + 4], P[BASE + 5]), b1 = cvtpk(P[BASE + 6], P[BASE + 7]);                              \
    auto r0 = __builtin_amdgcn_permlane32_swap(a0, b0, false, false); auto r1 = __builtin_amdgcn_permlane32_swap(a1, b1, false, false); \
    u32x4 w = {r0[0], r1[0], r0[1], r1[1]}; OUT = *reinterpret_cast<bf16x8*>(&w); } while (0)
  PK4(p0, 0, pa0); PK4(p0, 8, pa1); PK4(p1, 0, pa2); PK4(p1, 8, pa3);
#undef PK4
}
__device__ __forceinline__ void qkt(f32x16& p0, f32x16& p1, const bf16* Ks, const bf16x8* qr, int r32, int hi, int mp) {
#pragma unroll
  for (int d0 = 0; d0 < 4; ++d0) { int cb = (mp * 64 + d0 * 16 + hi * 8) * 2;
    bf16x8 b0 = *reinterpret_cast<const bf16x8*>((const char*)Ks + KSWZ(r32, cb));
    bf16x8 b1 = *reinterpret_cast<const bf16x8*>((const char*)Ks + KSWZ(32 + r32, cb));
    p0 = __builtin_amdgcn_mfma_f32_32x32x16_bf16(b0, qr[d0], p0, 0, 0, 0);
    p1 = __builtin_amdgcn_mfma_f32_32x32x16_bf16(b1, qr[d0], p1, 0, 0, 0); }
}
__device__ __forceinline__ void binit(f32x16& p0, f32x16& p1, const float* tb, int j, int qw0  , int qpos, int hi) {
  const int relmin = 64 * j - (qw0 + 31), relmax = 64 * j + 63 - qw0;
  if (relmax <= -128) { const float c = tb[0];
#pragma unroll
    for (int r = 0; r < 16; ++r) { p0[r] = c; p1[r] = c; } }
  else if (relmin >= 128) { const float c = tb[512];
#pragma unroll
    for (int r = 0; r < 16; ++r) { p0[r] = c; p1[r] = c; } }
  else { const float* t = tb + (64 * j - qpos + 256 + 4 * hi);
#pragma unroll
    for (int r = 0; r < 16; ++r) { p0[r] = t[(r & 3) + 8 * (r >> 2)]; p1[r] = t[32 + (r & 3) + 8 * (r >> 2)]; } }
}
__device__ __forceinline__ int v_st(int k, int c) { const int kk = (k & ~0xC) | ((k & 4) << 1) | ((k & 8) >> 1); return ((kk >> 3) * 4 + (c >> 5)) * 512 + ((kk & 7) * 32 + (c & 31)) * 2; }
__device__ __forceinline__ int v_rd_base(int lane) { return ((lane & 3) << 3) | (((lane >> 2) & 3) << 6) | (((lane >> 4) & 1) << 5) | (((lane >> 5) & 1) << 8); }
constexpr int v_rd_off(int d0, int ks, int half) { return d0 * 512 + ks * 4096 + half * 2048; }
template <int OFF> __device__ __forceinline__ s16x4 tr_read(int vb) {
  s16x4 r; asm volatile("ds_read_b64_tr_b16 %0, %1 offset:%2" : "=&v"(r) : "v"(vb), "i"(OFF) : "memory"); return r;
}
template <int D0> __device__ __forceinline__ void pv_one(f32x16& od, int vb, bf16x8 pa0, bf16x8 pa1, bf16x8 pa2, bf16x8 pa3) {
  const s16x4 l0 = tr_read<v_rd_off(D0, 0, 0)>(vb), h0 = tr_read<v_rd_off(D0, 0, 1)>(vb), l1 = tr_read<v_rd_off(D0, 1, 0)>(vb), h1 = tr_read<v_rd_off(D0, 1, 1)>(vb);
  const s16x4 l2 = tr_read<v_rd_off(D0, 2, 0)>(vb), h2 = tr_read<v_rd_off(D0, 2, 1)>(vb), l3 = tr_read<v_rd_off(D0, 3, 0)>(vb), h3 = tr_read<v_rd_off(D0, 3, 1)>(vb);
  asm volatile("s_waitcnt lgkmcnt(0)" ::: "memory"); SBAR();
#define PK(L, H) (bf16x8){L[0], L[1], L[2], L[3], H[0], H[1], H[2], H[3]}
  od = __builtin_amdgcn_mfma_f32_32x32x16_bf16(pa0, PK(l0, h0), od, 0, 0, 0);
  od = __builtin_amdgcn_mfma_f32_32x32x16_bf16(pa1, PK(l1, h1), od, 0, 0, 0);
  od = __builtin_amdgcn_mfma_f32_32x32x16_bf16(pa2, PK(l2, h2), od, 0, 0, 0);
  od = __builtin_amdgcn_mfma_f32_32x32x16_bf16(pa3, PK(l3, h3), od, 0, 0, 0);
#undef PK
}
__device__ __forceinline__ void pv_d0(f32x16* o, int vb, bf16x8 pa0, bf16x8 pa1, bf16x8 pa2, bf16x8 pa3) {
  pv_one<0>(o[0], vb, pa0, pa1, pa2, pa3); pv_one<1>(o[1], vb, pa0, pa1, pa2, pa3); pv_one<2>(o[2], vb, pa0, pa1, pa2, pa3); pv_one<3>(o[3], vb, pa0, pa1, pa2, pa3);
}

__device__ __forceinline__ void attn_unit(int b, int h, int qblk, const bf16* __restrict__ Q, const bf16* __restrict__ K, const bf16* __restrict__ V,
                                          unsigned short* __restrict__ YC, const float* __restrict__ rel_bias, const float* __restrict__ subln_g, float lam, char* lds) {
  const int tid = threadIdx.x, wid = __builtin_amdgcn_readfirstlane(tid >> 6), lane = tid & 63, r32 = lane & 31, hi = lane >> 5;
  const int qg = wid & 3, mp = wid >> 2;
  bf16* V_lds = (bf16*)(lds + OFF_V); bf16* K_lds = (bf16*)(lds + OFF_K);
  float* ws = (float*)(lds + OFF_WS) + wid * 64; float* li_l = ws; float* al_l = ws + 32;
  float* tb = (float*)(lds + OFF_TB);
  for (int i = tid; i < 513; i += 512) tb[i] = rel_bias[t5_bucket(i - 256) * 4 + h] * LOG2E;
  const long tok0 = (long)b * SEQ; const int q0 = qblk * 128, qw0 = q0 + qg * 32, qpos = qw0 + r32;
  float m_reg = -1e30f, l_reg = 0; f32x16 o[4] = {}; bf16x8 qr[4];
  const bf16* Qw = Q + (tok0 + qpos) * LDK + h * 128 + mp * 64 + hi * 8;
#pragma unroll
  for (int d0 = 0; d0 < 4; ++d0) qr[d0] = *reinterpret_cast<const bf16x8*>(Qw + d0 * 16);
  const bf16* Kh = K + tok0 * LDK + h * 128; const bf16* Vh = V + tok0 * LDK + h * 128;
  const int sr = tid >> 4, sc = (tid & 15) * 8, vst0 = v_st(sr, sc), vst1 = v_st(32 + sr, sc);
  const int vb0 = (int)(uintptr_t)V_lds + v_rd_base(lane); const unsigned voff = (unsigned)((sr * LDK + sc) * 2);
  struct { bf16x8 vs0, vs1, ks0, ks1; } sr_[1];
#define SLOAD(i, k0) do { const char* kb_ = (const char*)Kh + (size_t)(k0) * (LDK * 2); const char* vb_ = (const char*)Vh + (size_t)(k0) * (LDK * 2); \
    sr_[i].vs0 = *reinterpret_cast<const bf16x8*>(vb_ + voff); sr_[i].vs1 = *reinterpret_cast<const bf16x8*>(vb_ + 32 * LDK * 2 + voff); \
    sr_[i].ks0 = *reinterpret_cast<const bf16x8*>(kb_ + voff); sr_[i].ks1 = *reinterpret_cast<const bf16x8*>(kb_ + 32 * LDK * 2 + voff); } while (0)
#define SWRITE(bb, i) do { *(bf16x8*)((char*)V_lds + (bb) * SHM_V + vst0) = sr_[i].vs0;          \
    *(bf16x8*)((char*)V_lds + (bb) * SHM_V + vst1) = sr_[i].vs1; int kc = sc * 2;               \
    *(bf16x8*)((char*)K_lds + (bb) * SHM_K + KSWZ(sr, kc)) = sr_[i].ks0;                       \
    *(bf16x8*)((char*)K_lds + (bb) * SHM_K + KSWZ(32 + sr, kc)) = sr_[i].ks1; } while (0)
#define SWAIT() asm volatile("s_waitcnt vmcnt(0)" ::: "memory")
#define RESC(a) do { if (__any((a) < 1.f)) { if (hi == 0) al_l[r32] = (a); asm volatile("s_waitcnt lgkmcnt(0)" ::: "memory"); \
    _Pragma("unroll") for (int d = 0; d < 4; ++d) _Pragma("unroll") for (int r = 0; r < 16; ++r) o[d][r] *= al_l[crow(r, hi)]; } } while (0)
  f32x16 pA0, pA1, pB0, pB1; float mnA, mnB, alA, alB; bf16x8 pa0, pa1, pa2, pa3; constexpr int NT = SEQ / KVBLK;
  constexpr int SE = 0, SO = 0;
  SLOAD(SE, 0); asm volatile("s_waitcnt vmcnt(0)" ::: "memory"); SWRITE(0, SE); __syncthreads();
  binit(pA0, pA1, tb, 0, qw0, qpos, hi);
  qkt(pA0, pA1, K_lds, qr, r32, hi, mp); partialSM(pA0, pA1, m_reg, mnA, alA);
  SLOAD(SO, KVBLK);
  SWAIT(); SWRITE(1, SO); __syncthreads();
  for (int j = 1; j + 1 < NT; j += 2) {
    binit(pB0, pB1, tb, j, qw0, qpos, hi);
    SBAR(); qkt(pB0, pB1, (bf16*)((char*)K_lds + SHM_K), qr, r32, hi, mp);
    finishSM(pA0, pA1, alA, l_reg, pa0, pa1, pa2, pa3); SBAR();
    SLOAD(SO, (j + 1) * KVBLK); SBAR();
    pv_d0(o, vb0, pa0, pa1, pa2, pa3); partialSM(pB0, pB1, m_reg, mnB, alB);
    __syncthreads(); SWAIT(); SWRITE(0, SE);
    RESC(alB); __syncthreads();
    binit(pA0, pA1, tb, j + 1, qw0, qpos, hi);
    SBAR(); qkt(pA0, pA1, K_lds, qr, r32, hi, mp);
    finishSM(pB0, pB1, alB, l_reg, pa0, pa1, pa2, pa3); SBAR();
    SLOAD(SE, (j + 2) * KVBLK); SBAR();
    pv_d0(o, vb0 + (int)SHM_V, pa0, pa1, pa2, pa3); partialSM(pA0, pA1, m_reg, mnA, alA);
    __syncthreads(); SWAIT(); SWRITE(1, SO);
    RESC(alA); __syncthreads();
  }
  binit(pB0, pB1, tb, NT - 1, qw0, qpos, hi);
  SBAR(); qkt(pB0, pB1, (bf16*)((char*)K_lds + SHM_K), qr, r32, hi, mp);
  finishSM(pA0, pA1, alA, l_reg, pa0, pa1, pa2, pa3); SBAR();
  pv_d0(o, vb0, pa0, pa1, pa2, pa3); partialSM(pB0, pB1, m_reg, mnB, alB);
  __syncthreads(); RESC(alB);
  finishSM(pB0, pB1, alB, l_reg, pa0, pa1, pa2, pa3); SBAR();
  pv_d0(o, vb0 + (int)SHM_V, pa0, pa1, pa2, pa3);
  if (hi == 0) li_l[r32] = l_reg; asm volatile("s_waitcnt lgkmcnt(0)" ::: "memory");
  float rli[16]; const float scm = (mp == 0) ? 1.f : lam;
#pragma unroll
  for (int r = 0; r < 16; ++r) rli[r] = scm * __builtin_amdgcn_rcpf(li_l[crow(r, hi)]);
  float* X = (float*)(lds + OFF_X) + qg * X_FLOATS;
  if (mp == 1) {
#pragma unroll
    for (int r = 0; r < 16; ++r)
#pragma unroll
      for (int d0 = 0; d0 < 4; ++d0) X[crow(r, hi) * XS + d0 * 32 + r32] = o[d0][r] * rli[r];
  }
  __syncthreads();
  if (mp == 0) {
#pragma unroll
    for (int r = 0; r < 16; ++r)
#pragma unroll
      for (int d0 = 0; d0 < 4; ++d0) { float* p = &X[crow(r, hi) * XS + d0 * 32 + r32]; *p = o[d0][r] * rli[r] - *p; }
    asm volatile("s_waitcnt lgkmcnt(0)" ::: "memory");
    const int row = lane >> 1, hf = lane & 1;
    f32x4 v[16]; float ss = 0.f;
#pragma unroll
    for (int i = 0; i < 16; ++i) { v[i] = *(const f32x4*)&X[row * XS + hf * 64 + i * 4]; ss += (v[i][0] * v[i][0] + v[i][1] * v[i][1]) + (v[i][2] * v[i][2] + v[i][3] * v[i][3]); }
    ss += __shfl_xor(ss, 1);
    const float rs = 0.8f / sqrtf(ss * (1.f / 128.f) + EPS);
    unsigned short* dst = YC + (size_t)(tok0 + qw0 + row) * 1024 + 512 + h * 128 + hf * 64;
#pragma unroll
    for (int i = 0; i < 8; ++i) { const f32x4 g0 = *(const f32x4*)(subln_g + hf * 64 + i * 8), g1 = *(const f32x4*)(subln_g + hf * 64 + i * 8 + 4);
      const f32x4 a = v[2 * i] * g0 * rs, c = v[2 * i + 1] * g1 * rs;
      u32x4 w = {cvtpk(a[0], a[1]), cvtpk(a[2], a[3]), cvtpk(c[0], c[1]), cvtpk(c[2], c[3])}; *(u32x4*)(dst + i * 8) = w; }
  }
  __syncthreads();
#undef SLOAD
#undef SWRITE
#undef SWAIT
#undef RESC
}
#undef SBAR
}

constexpr int NWAVES = 8;
constexpr size_t MiB = 1u << 20;
constexpr size_t WS_CTL = 0, CTL_ZERO_BYTES = 64 * 1024;
constexpr size_t WS_G = 1 * MiB;
constexpr size_t WS_WQKV = 2 * MiB;
constexpr size_t WS_WF = 5 * MiB;
constexpr size_t WS_WO = 7 * MiB;
constexpr size_t WS_WUP = 9 * MiB;
constexpr size_t WS_WD = 20 * MiB;
constexpr size_t WS_XN = 26 * MiB;
constexpr int XN_ROWS = 1 + M + 129;
constexpr size_t WS_Q = 59 * MiB, WS_K = 75 * MiB, WS_V = 91 * MiB;
constexpr size_t WS_UT = 107 * MiB;
constexpr size_t WS_DM = 139 * MiB;
constexpr size_t WS_YC = 203 * MiB;
constexpr size_t WS_ACT = 59 * MiB;
constexpr size_t WS_END = 235 * MiB;
static_assert(WS_XN + (size_t)XN_ROWS * 2048 <= WS_Q && WS_ACT + (size_t)M * DFF * 2 <= WS_YC, "ws map");
constexpr int CW_TMO = 0, CW_BAR = 4096;

constexpr int RING_OFF = 0, RING_BYTES = 131072;
constexpr int XCH_OFF = RING_BYTES;
constexpr int LDSCTL_OFF = 147456, MISC_OFF = LDSCTL_OFF + 320;
constexpr int LDS_BYTES = LDSCTL_OFF + 1024;
static_assert(att::LDS_BYTES <= LDSCTL_OFF && XCH_OFF + 8192 <= LDSCTL_OFF, "LDS map");

#define GAS __attribute__((address_space(1)))
#define LAS __attribute__((address_space(3)))
typedef unsigned short bf16;
typedef unsigned v4u __attribute__((ext_vector_type(4)));
typedef float f32x4 __attribute__((ext_vector_type(4)));
typedef GAS unsigned gu32;
#define RLX_AGENT __ATOMIC_RELAXED, __HIP_MEMORY_SCOPE_AGENT
#define LDS_WAIT() asm volatile("s_waitcnt lgkmcnt(0)" ::: "memory")
#define VM_WAIT() asm volatile("s_waitcnt vmcnt(0)" ::: "memory")
__device__ __forceinline__ unsigned f2bf(float f) { unsigned u = __builtin_bit_cast(unsigned, f); return (u + 0x7fffu + ((u >> 16) & 1u)) >> 16; }
__device__ __forceinline__ unsigned pk2(float lo, float hi) { return f2bf(lo) | (f2bf(hi) << 16); }

#define XB_TMO      128
#define XB_XCNT(j)  (256  + 64 * (j))
#define XB_XSUB(j)  (1280 + 64 * (j))
#define XB_XGEN(j)  (2304 + 64 * (j))
#define XB_TOP      3328
#define XB_TOPGEN   3392
#define XCD_BAR_WORDS 3456
#define XB_SPIN_CAP (1u << 22)
__device__ __forceinline__ unsigned xb_ld(unsigned* p)              { return __hip_atomic_load(p, __ATOMIC_RELAXED, __HIP_MEMORY_SCOPE_AGENT); }
__device__ __forceinline__ unsigned xb_add(unsigned* p, unsigned v) { return __hip_atomic_fetch_add(p, v, __ATOMIC_RELAXED, __HIP_MEMORY_SCOPE_AGENT); }
__device__ __forceinline__ unsigned xb_xcc_id() { return (unsigned)__builtin_amdgcn_s_getreg((3 << 11) | 20) & 0xFu; }
#define XB_SPIN(cond, bar) do { unsigned _sp = 0; while (cond) { __builtin_amdgcn_s_sleep(1); \
    if ((++_sp & 255u) == 0u) { if (xb_ld(&(bar)[XB_TMO])) break; if (_sp > XB_SPIN_CAP) { atomicAdd(&(bar)[XB_TMO], 1u); break; } } } } while (0)
struct XcdBarrier { unsigned* bar; unsigned x; volatile LAS unsigned* st; };
__device__ __forceinline__ XcdBarrier xcd_barrier_post(unsigned* bar, volatile LAS unsigned* st) {
    XcdBarrier b; b.bar = bar; b.x = xb_xcc_id(); b.st = st;
    if (threadIdx.x == 0) (void)xb_add(&bar[XB_XCNT(b.x)], 1u);
    return b;
}
__device__ __forceinline__ void xcd_barrier_complete(unsigned* bar, unsigned x, unsigned& nloc, unsigned& nx) {
    const unsigned G = gridDim.x * gridDim.y * gridDim.z;
    unsigned sum, cnt, mine, sp = 0u;
    for (;;) {
        sum = 0u; cnt = 0u; mine = 0u;
#pragma unroll
        for (unsigned j = 0; j < 16; ++j) { const unsigned c = xb_ld(&bar[XB_XCNT(j)]); sum += c; cnt += (c > 0u) ? 1u : 0u; mine = (j == x) ? c : mine; }
        if (sum == G) break;
        __builtin_amdgcn_s_sleep(1);
        if ((++sp & 255u) == 0u) { if (xb_ld(&bar[XB_TMO])) break; if (sp > XB_SPIN_CAP) { atomicAdd(&bar[XB_TMO], 1u); break; } }
    }
    nloc = mine > 0u ? mine : 1u; nx = cnt > 0u ? cnt : 1u;
}
__device__ __forceinline__ void xcd_barrier(const XcdBarrier& b) {
    asm volatile("s_waitcnt vmcnt(0)" ::: "memory");
    __syncthreads();
    if (threadIdx.x == 0) {
        unsigned* bar = b.bar;
        __builtin_amdgcn_s_waitcnt(0);
        unsigned nloc = b.st[0], nx = b.st[1];
        if (nloc == 0u) { xcd_barrier_complete(bar, b.x, nloc, nx); b.st[0] = nloc; b.st[1] = nx; }
        const unsigned old = xb_add(&bar[XB_XSUB(b.x)], 1u);
        const unsigned gen = old / nloc;
        if (old + 1u == (gen + 1u) * nloc) {
            __builtin_amdgcn_fence(__ATOMIC_RELEASE, "agent");
            asm volatile("s_waitcnt vmcnt(0)" ::: "memory");
            const unsigned og = xb_add(&bar[XB_TOP], 1u);
            const unsigned tg = og / nx;
            if (og + 1u == (tg + 1u) * nx) xb_add(&bar[XB_TOPGEN], 1u);
            else XB_SPIN(xb_ld(&bar[XB_TOPGEN]) == tg, bar);
            __builtin_amdgcn_fence(__ATOMIC_ACQUIRE, "agent");
            xb_add(&bar[XB_XGEN(b.x)], 1u);
            asm volatile("s_waitcnt vmcnt(0)" ::: "memory");
        } else {
            XB_SPIN(xb_ld(&bar[XB_XGEN(b.x)]) == gen, bar);
            __builtin_amdgcn_fence(__ATOMIC_ACQUIRE, "agent");
            asm volatile("s_waitcnt vmcnt(0)" ::: "memory");
        }
    }
    __syncthreads();
}

struct Frame {
    LAS unsigned char* lds;
    volatile LAS unsigned* MISC;
    gu32* ctl;
    int tid, lane, wave, vcu, G;
};
__device__ __forceinline__ float wave_sum(float v) {
#pragma unroll
    for (int o = 1; o < 64; o <<= 1) v += __shfl_xor(v, o);
    return v;
}
__device__ __forceinline__ void p0_transpose_item(const float* W, int ldw, int K, int N, bf16* WT, LAS float* scr, int item, int lane) {
    const int nblk = N / 32, kb = item / nblk, nb = item % nblk, k0 = 64 * kb, n0 = 32 * nb;
#pragma unroll 8
    for (int i = 0; i < 32; ++i) { const int kk = 2 * i + (lane >> 5); scr[kk * 33 + (lane & 31)] = W[(size_t)(k0 + kk) * ldw + n0 + (lane & 31)]; }
    LDS_WAIT(); asm volatile("" ::: "memory");
    const int c = lane & 7;
#pragma unroll
    for (int j = 0; j < 4; ++j) { const int n = (lane >> 3) + 8 * j; const LAS float* s = scr + (8 * c) * 33 + n;
        v4u o; o.x = pk2(s[0 * 33], s[1 * 33]); o.y = pk2(s[2 * 33], s[3 * 33]); o.z = pk2(s[4 * 33], s[5 * 33]); o.w = pk2(s[6 * 33], s[7 * 33]);
        *(GAS v4u*)(WT + (size_t)(n0 + n) * K + k0 + 8 * c) = o; }
    LDS_WAIT(); asm volatile("" ::: "memory");
}
__device__ __forceinline__ void rms_row_to_bf16(int lane, const float* xrow, const float* g, bf16* orow) {
    const GAS f32x4* xr = (const GAS f32x4*)xrow + lane; const GAS f32x4* gr = (const GAS f32x4*)g + lane;
    f32x4 v[4]; float s = 0.f;
#pragma unroll
    for (int j = 0; j < 4; ++j) { v[j] = xr[64 * j]; s += (v[j].x * v[j].x + v[j].y * v[j].y) + (v[j].z * v[j].z + v[j].w * v[j].w); }
    const float rstd = 1.f / sqrtf(wave_sum(s) * (1.f / D) + EPS);
    GAS unsigned long long* o8 = (GAS unsigned long long*)orow + lane;
#pragma unroll
    for (int j = 0; j < 4; ++j) { const f32x4 gg = gr[64 * j];
        o8[64 * j] = (unsigned long long)pk2(v[j].x * rstd * gg.x, v[j].y * rstd * gg.y) | ((unsigned long long)pk2(v[j].z * rstd * gg.z, v[j].w * rstd * gg.w) << 32); }
}
__device__ __forceinline__ void rms_row_f32(int lane, const float* xrow, const float* g, float* orow) {
    const GAS f32x4* xr = (const GAS f32x4*)xrow + lane; const GAS f32x4* gr = (const GAS f32x4*)g + lane;
    f32x4 v[4]; float s = 0.f;
#pragma unroll
    for (int j = 0; j < 4; ++j) { v[j] = xr[64 * j]; s += (v[j].x * v[j].x + v[j].y * v[j].y) + (v[j].z * v[j].z + v[j].w * v[j].w); }
    const float rstd = 1.f / sqrtf(wave_sum(s) * (1.f / D) + EPS);
    GAS f32x4* o = (GAS f32x4*)orow + lane;
#pragma unroll
    for (int j = 0; j < 4; ++j) o[64 * j] = v[j] * rstd * gr[64 * j];
}

struct Args { const float* in[18]; float* out; unsigned char* ws; int ph_lo, ph_hi, li, pad; };

__global__ void __launch_bounds__(NWAVES * 64, 2) enc_fwd(Args args) {
    extern __shared__ __attribute__((aligned(16))) unsigned char lds[];
    Frame F;
    F.lds = (LAS unsigned char*)lds;
    F.MISC = (volatile LAS unsigned*)(F.lds + MISC_OFF);
    F.tid = threadIdx.x; F.lane = F.tid & 63; F.wave = __builtin_amdgcn_readfirstlane(F.tid >> 6);
    F.G = gridDim.x; { const int bx = blockIdx.x; F.vcu = (F.G % 8 == 0) ? (bx % 8) * (F.G / 8) + bx / 8 : bx; }
    unsigned char* ws = args.ws;
    F.ctl = (gu32*)(ws + WS_CTL);
    const float* x = args.in[0]; const float* norm_mix_g = args.in[1]; const float* w_in = args.in[2]; const float* fourier_w = args.in[3]; const float* fourier_b = args.in[4];
    const float* lq1 = args.in[5]; const float* lk1 = args.in[6]; const float* lq2 = args.in[7]; const float* lk2 = args.in[8]; const float* subln_g = args.in[9];
    const float* rel_bias = args.in[10]; const float* w_out = args.in[11]; const float* norm_ffn_g = args.in[12]; const float* w_up = args.in[13];
    const float* conv_w = args.in[14]; const float* conv_b = args.in[15]; const float* w_down = args.in[16]; const float* norm_final_g = args.in[17];
    float* out = args.out;
    float* Gt = (float*)(ws + WS_G);
    bf16* Wqkv_t = (bf16*)(ws + WS_WQKV); bf16* Wf_t = (bf16*)(ws + WS_WF); bf16* Wo_t = (bf16*)(ws + WS_WO); bf16* Wup_t = (bf16*)(ws + WS_WUP); bf16* Wd_t = (bf16*)(ws + WS_WD);
    bf16* XN = (bf16*)(ws + WS_XN); bf16* Qb = (bf16*)(ws + WS_Q); bf16* Kb = (bf16*)(ws + WS_K); bf16* Vb = (bf16*)(ws + WS_V);
    bf16* UT = (bf16*)(ws + WS_UT); bf16* DM = (bf16*)(ws + WS_DM); bf16* YC = (bf16*)(ws + WS_YC); bf16* ACT = (bf16*)(ws + WS_ACT);

    for (int u = F.tid; u < (LDS_BYTES - LDSCTL_OFF) / 4; u += NWAVES * 64) ((LAS unsigned*)(F.lds + LDSCTL_OFF))[u] = 0u;
    __syncthreads();
    XcdBarrier bar; bar.bar = (unsigned*)(F.ctl + CW_BAR); bar.x = 0; bar.st = nullptr;
    if (MK_N_LAUNCHES == 1) bar = xcd_barrier_post((unsigned*)(F.ctl + CW_BAR), F.MISC + 8);
#define GRID_BAR() do { if (MK_N_LAUNCHES == 1) xcd_barrier(bar); } while (0)
    const int lo = args.ph_lo, hi = args.ph_hi;
#ifndef PH_MASK
#define PH_MASK 0x3ff
#endif
#define IN(k) (((PH_MASK >> (k)) & 1) && lo <= (k) && (k) < hi)
#define BOTH(k) (IN(k) && IN((k) + 1))
    const int gw = F.vcu * NWAVES + F.wave, NGW = F.G * NWAVES;
    const int gt = blockIdx.x * (NWAVES * 64) + F.tid, NGT = F.G * NWAVES * 64;

    if (IN(0)) {
        { LAS float* ct = (LAS float*)(F.lds + RING_OFF);
          if (F.tid < 128) ct[F.tid] = cospif((float)F.tid * (1.f / 64.f));
          __syncthreads();
          for (int idx = gt; idx < 2 * 4 * 128 * 128; idx += NGT) {
              const int d = idx & 127, c = (idx >> 7) & 127, g = (idx >> 14) & 3, part = idx >> 16;
              const float* wg = fourier_w + (size_t)g * 16384 + d; float s = 0.f;
              for (int cp = 0; cp < 128; ++cp) { const int mm = (c * cp) & 127; const float t = part == 0 ? ct[mm] : ct[(mm - 32) & 127]; s += t * wg[cp * 128]; }
              Gt[idx] = s * 0.08838834764831845f;
          }
          __syncthreads(); }
        { LAS float* scr = (LAS float*)(F.lds + RING_OFF + F.wave * 16384);
          constexpr int I_QKV = 16 * 48, I_O = 16 * 32, I_UP = 16 * 176, I_D = 44 * 32, NITEMS = I_QKV + I_O + I_UP + I_D;
          for (int it = gw; it < NITEMS; it += NGW) {
              int r = it;
              if (r < I_QKV) { p0_transpose_item(w_in + 512, 2048, 1024, 1536, Wqkv_t, scr, r, F.lane); continue; } r -= I_QKV;
              if (r < I_O) { p0_transpose_item(w_out, 1024, 1024, 1024, Wo_t, scr, r, F.lane); continue; } r -= I_O;
              if (r < I_UP) { p0_transpose_item(w_up, NUP, 1024, NUP, Wup_t, scr, r, F.lane); continue; } r -= I_UP;
              p0_transpose_item(w_down, 1024, DFF, 1024, Wd_t, scr, r, F.lane);
          } }
        for (int m = gw; m < M; m += NGW) rms_row_to_bf16(F.lane, x + (size_t)m * D, norm_mix_g, XN + (size_t)(m + 1) * D);
        for (int idx = gt; idx < 130 * 128; idx += NGT) { const int r = idx >> 7, c = idx & 127; const int row = (r == 0) ? 0 : (M + r);
            *(GAS v4u*)(XN + (size_t)row * D + c * 8) = (v4u){0u, 0u, 0u, 0u}; }
        { __syncthreads();
          LAS float* ct = (LAS float*)(F.lds + RING_OFF);
          for (int i = F.tid; i < 4096; i += NWAVES * 64) ct[i] = cospif((float)i * (1.f / 2048.f)) * (1.f / 64.f);
          __syncthreads();
          for (int idx = gt; idx < 4096 * 1024; idx += NGT) {
              const int sp = idx >> 10, k0 = (idx & 1023) * 8; const int kk = k0 & 4095, sh = (k0 >= 4096) ? 1024 : 0;
              float v[8];
#pragma unroll
              for (int e = 0; e < 8; ++e) v[e] = ct[(sp * (kk + e) + sh) & 4095];
              *(GAS v4u*)(DM + (size_t)sp * 8192 + k0) = (v4u){pk2(v[0], v[1]), pk2(v[2], v[3]), pk2(v[4], v[5]), pk2(v[6], v[7])};
          }
          __syncthreads(); }
        if (BOTH(0)) GRID_BAR();
    }
    if (IN(1)) {
        LAS float* wl = (LAS float*)(F.lds + RING_OFF);
        for (int item = blockIdx.x; item < 128; item += F.G) {
            const int part = item >> 6, g = (item >> 4) & 3, kb = item & 15;
            __syncthreads();
            for (int i = F.tid; i < 64 * 32; i += NWAVES * 64) { const int kk = i >> 5, c4 = (i & 31) * 4;
                *(LAS f32x4*)(wl + kk * 128 + c4) = *(const f32x4*)(w_in + (size_t)(kb * 64 + kk) * 2048 + g * 128 + c4); }
            __syncthreads();
            const int d = F.tid & 127, kq = F.tid >> 7;
            const float* Gp = Gt + (size_t)(part * 4 + g) * 16384 + d;
            float acc[16];
#pragma unroll
            for (int j = 0; j < 16; ++j) acc[j] = 0.f;
            for (int c4 = 0; c4 < 128; c4 += 4) {
                const float g0 = Gp[(c4 + 0) * 128], g1 = Gp[(c4 + 1) * 128], g2 = Gp[(c4 + 2) * 128], g3 = Gp[(c4 + 3) * 128];
#pragma unroll
                for (int j = 0; j < 16; ++j) { const f32x4 w = *(const LAS f32x4*)(wl + (kq * 16 + j) * 128 + c4); acc[j] += (w.x * g0 + w.y * g1) + (w.z * g2 + w.w * g3); }
            }
            bf16* dst = Wf_t + (size_t)(part * 512 + g * 128 + d) * 1024 + kb * 64 + kq * 16;
            *(GAS v4u*)(dst) = (v4u){pk2(acc[0], acc[1]), pk2(acc[2], acc[3]), pk2(acc[4], acc[5]), pk2(acc[6], acc[7])};
            *(GAS v4u*)(dst + 8) = (v4u){pk2(acc[8], acc[9]), pk2(acc[10], acc[11]), pk2(acc[12], acc[13]), pk2(acc[14], acc[15])};
        }
        __syncthreads();
        if (BOTH(1)) GRID_BAR();
    }
    if (IN(2)) {
        { pg8::Gemm g{XN + D, Wqkv_t, D, (size_t)256 * D * 2, (size_t)128 * D * 2, (size_t)256 * D * 2, (size_t)128 * D * 2};
          pg8::StaticOrder S; S.init(M / 256, 1536 / 256, F.G, (int)blockIdx.x);
          pg8::EpiQKV E{Qb, (size_t)(WS_K - WS_Q) / 2, 0.125f * LOG2E};
          pg8::gemm_phase<pg8::EpiQKV, pg8::StaticOrder>(F.lds + RING_OFF, g, S, E); }
        { pg8::Gemm g{Wf_t, XN + D, D, (size_t)256 * D * 2, (size_t)128 * D * 2, (size_t)256 * D * 2, (size_t)128 * D * 2};
          pg8::StaticOrder S; S.init(1024 / 256, M / 256, F.G, (int)blockIdx.x);
          pg8::EpiUT E{UT};
          pg8::gemm_phase<pg8::EpiUT, pg8::StaticOrder>(F.lds + RING_OFF, g, S, E); }
        if (BOTH(2)) GRID_BAR();
    }
    if (IN(3)) {
        float lam;
        { const float a = lq1[F.lane] * lk1[F.lane], c = lq2[F.lane] * lk2[F.lane]; lam = expf(wave_sum(a)) - expf(wave_sum(c)) + 0.2f; }
        for (int uix = F.vcu; uix < 512; uix += F.G) {
            const int grp = uix / 32, qblk = uix % 32; const int b = grp >> 2, h = grp & 3;
            att::attn_unit(b, h, qblk, (const att::bf16*)Qb, (const att::bf16*)Kb, (const att::bf16*)Vb, YC, rel_bias, subln_g, lam, (char*)lds);
        }
        if (BOTH(3)) GRID_BAR();
    }
    if (IN(4)) {
        pg8::Gemm g{DM, UT, 8192, (size_t)256 * 8192 * 2, (size_t)128 * 8192 * 2, (size_t)256 * 8192 * 2, (size_t)128 * 8192 * 2};
        pg8::StaticOrder S; S.init(4096 / 256, 2048 / 256, F.G, (int)blockIdx.x);
        pg8::EpiDFT E{YC, fourier_b};
        pg8::gemm_phase<pg8::EpiDFT, pg8::StaticOrder>(F.lds + RING_OFF, g, S, E);
        if (BOTH(4)) GRID_BAR();
    }
    if (IN(5)) {
        pg8::Gemm g{YC, Wo_t, D, (size_t)256 * D * 2, (size_t)128 * D * 2, (size_t)256 * D * 2, (size_t)128 * D * 2};
        pg8::StaticOrder S; S.init(M / 256, D / 256, F.G, (int)blockIdx.x);
        pg8::EpiResF32 E{x, out};
        pg8::gemm_phase<pg8::EpiResF32, pg8::StaticOrder>(F.lds + RING_OFF, g, S, E);
        if (BOTH(5)) GRID_BAR();
    }
    if (IN(6)) {
        for (int m = gw; m < M; m += NGW) rms_row_to_bf16(F.lane, out + (size_t)m * D, norm_ffn_g, XN + (size_t)(m + 1) * D);
        if (BOTH(6)) GRID_BAR();
    }
    if (IN(7)) {
        pg8::Gemm g{XN, Wup_t, D, (size_t)254 * D * 2, (size_t)128 * D * 2, (size_t)128 * D * 2, (size_t)DFF * D * 2};
        pg8::StaticOrder S; S.init(65, 22, F.G, (int)blockIdx.x);
        pg8::EpiConvAct E{ACT, conv_w, conv_b, (LAS float*)(F.lds + XCH_OFF)};
        pg8::gemm_phase<pg8::EpiConvAct, pg8::StaticOrder>(F.lds + RING_OFF, g, S, E);
        if (BOTH(7)) GRID_BAR();
    }
    if (IN(8)) {
        pg8::Gemm g{ACT, Wd_t, DFF, (size_t)256 * DFF * 2, (size_t)128 * DFF * 2, (size_t)256 * DFF * 2, (size_t)128 * DFF * 2};
        pg8::StaticOrder S; S.init(M / 256, D / 256, F.G, (int)blockIdx.x);
        pg8::EpiResF32 E{out, out};
        pg8::gemm_phase<pg8::EpiResF32, pg8::StaticOrder>(F.lds + RING_OFF, g, S, E);
        if (BOTH(8)) GRID_BAR();
    }
    if (IN(9)) {
        for (int m = gw; m < M; m += NGW) rms_row_f32(F.lane, out + (size_t)m * D, norm_final_g, out + (size_t)m * D);
    }
#undef IN
#undef BOTH
}

extern "C" void kernel_launch(void* const* d_in, const int* in_sizes, int n_in, void* d_out, int out_size, void* d_ws, size_t ws_size, hipStream_t stream) {
    static int grid = 0;
    if (grid == 0) {
        if (n_in != 18 || in_sizes[0] != M * D || out_size != M * D || ws_size < WS_END) { fprintf(stderr, "kernel_launch: unexpected shapes (n_in %d, in0 %d, out %d, ws %zu)\n", n_in, n_in > 0 ? in_sizes[0] : -1, out_size, ws_size); grid = -1; return; }
        int dev = 0, cus = 0, per_cu = 0;
        if (hipGetDevice(&dev) != hipSuccess || hipDeviceGetAttribute(&cus, hipDeviceAttributeMultiprocessorCount, dev) != hipSuccess) { grid = -1; return; }
        if (hipFuncSetAttribute((const void*)enc_fwd, hipFuncAttributeMaxDynamicSharedMemorySize, LDS_BYTES) != hipSuccess) { fprintf(stderr, "kernel_launch: hipFuncSetAttribute failed\n"); grid = -1; return; }
        if (hipOccupancyMaxActiveBlocksPerMultiprocessor(&per_cu, (const void*)enc_fwd, NWAVES * 64, LDS_BYTES) != hipSuccess || per_cu < 1) { fprintf(stderr, "kernel_launch: occupancy query says %d blocks per CU\n", per_cu); }
        (void)hipGetLastError();
        grid = cus;
    }
    if (grid < 0) return;
    (void)hipMemsetAsync((char*)d_ws + WS_CTL, 0, CTL_ZERO_BYTES, stream);
    Args a{};
    for (int i = 0; i < 18; ++i) a.in[i] = (const float*)d_in[i];
    a.out = (float*)d_out; a.ws = (unsigned char*)d_ws;
    if (MK_N_LAUNCHES == 1) {
        a.ph_lo = 0; a.ph_hi = N_PHASES; a.li = 0;
        hipLaunchKernelGGL(enc_fwd, dim3(grid), dim3(NWAVES * 64), LDS_BYTES, stream, a);
    } else {
        for (int li = 0; li < N_PHASES; ++li) { a.ph_lo = li; a.ph_hi = li + 1; a.li = li;
            hipLaunchKernelGGL(enc_fwd, dim3(grid), dim3(NWAVES * 64), LDS_BYTES, stream, a); }
    }
}
```

```cpp
#include <hip/hip_runtime.h>
#include <hip/hip_bf16.h>
#include <cstdio>
#include <cstdint>

#ifndef MK_N_LAUNCHES
#define MK_N_LAUNCHES 1
#endif
constexpr int N_PHASES = 10;

constexpr int D = 1024, BATCH = 4, SEQ = 4096, M = BATCH * SEQ, FW = 512, NH = 4, DFF = 2816, NUP = 2 * DFF;
constexpr float EPS = 1e-6f, LOG2E = 1.4426950408889634f;

namespace pg8 {
#define PG8_LAS __attribute__((address_space(3)))
typedef unsigned short bf16_t;
typedef short bf16x8 __attribute__((ext_vector_type(8)));
typedef float f32x4 __attribute__((ext_vector_type(4)));
typedef unsigned u32x4 __attribute__((ext_vector_type(4)));
typedef unsigned u32x2 __attribute__((ext_vector_type(2)));
constexpr int BM = 256, BK = 64, HALF = 128, HTB = HALF * BK * 2, STAGE_BYTES = 8 * HTB, NXCD = 8, WGM = 8;

__host__ __device__ __forceinline__ int lds_byte(int r, int c) { const int st = (r >> 4) * 2 + (c >> 5), rr = r & 15, cc = c & 31, ob = rr * 64 + cc * 2; return st * 1024 + (ob ^ (((ob >> 9) & 1) << 5)); }
__host__ __device__ __forceinline__ void stage_rc(int b, int& R, int& C) { const int st = b / 1024, sb = b % 1024, swz = sb ^ (((sb >> 9) & 1) << 5); R = (st >> 1) * 16 + swz / 64; C = (st & 1) * 32 + (swz % 64) / 2; }
__host__ __device__ __forceinline__ int perm32(int rho) { const int n = rho >> 4, i = rho & 15; return 8 * (i >> 2) + 4 * n + (i & 3); }

struct Unit { int pm, pn; };
struct Gemm { const bf16_t* A; const bf16_t* Bt; int K; size_t tstepA, hstepA, tstepB, hstepB; int pmsh; size_t bpm; };
struct OneUnit { int pm, pn; bool has; __device__ __forceinline__ bool next(int i, Unit& u) const { if (i > 0 || !has) return false; u.pm = pm; u.pn = pn; return true; } };

struct StaticOrder {
    int nM, nN, nwg, G, c;
    __host__ __device__ void init(int nM_, int nN_, int G_, int c_) { nM = nM_; nN = nN_; nwg = nM * nN; G = G_; c = c_; }
    __host__ __device__ bool next(int i, Unit& u) const {
        const long L = (long)i * G + c; if (L >= nwg) return false;
        int wgid = (int)L; { const int q = nwg / NXCD, r = nwg % NXCD, xcd = wgid % NXCD, off = wgid / NXCD; wgid = (xcd < r ? xcd * (q + 1) : r * (q + 1) + (xcd - r) * q) + off; }
        const int nig = WGM * nN, gid = wgid / nig, fm = gid * WGM, gsz = (nM - fm) < WGM ? (nM - fm) : WGM;
        u.pm = fm + ((wgid % nig) % gsz); u.pn = (wgid % nig) / gsz; return true;
    }
};

__device__ __forceinline__ unsigned cvt_pk_bf16(float lo, float hi) { unsigned r; asm volatile("v_cvt_pk_bf16_f32 %0, %1, %2" : "=v"(r) : "v"(lo), "v"(hi)); return r; }


struct EpiQKV {
    static constexpr bool PERM = true, NEEDS_SYNC = false;
    bf16_t* O; size_t split_stride; float scale0;
    __device__ __forceinline__ void operator()(const f32x4 (&acc)[2][2][4][2], const Unit& u, int wr, int wc, int fr, int fq) const {
        const int row0 = u.pm * BM + wr * 64 + fr; int colt = u.pn * BM; bf16_t* base = O;
        const int t = colt / 512; base += (size_t)t * split_stride; colt -= t * 512; const float sc = (t == 0) ? scale0 : 1.f;
        const int col0 = colt + wc * 32 + 8 * fq;
#pragma unroll
        for (int ai = 0; ai < 2; ++ai)
#pragma unroll
            for (int m = 0; m < 4; ++m) { bf16_t* rowp = base + (size_t)(row0 + ai * HALF + m * 16) * 512 + col0;
#pragma unroll
                for (int bj = 0; bj < 2; ++bj) { f32x4 v0 = acc[ai][bj][m][0] * sc, v1 = acc[ai][bj][m][1] * sc;
                    u32x4 w; w.x = cvt_pk_bf16(v0[0], v0[1]); w.y = cvt_pk_bf16(v0[2], v0[3]); w.z = cvt_pk_bf16(v1[0], v1[1]); w.w = cvt_pk_bf16(v1[2], v1[3]);
                    *(u32x4*)(rowp + bj * HALF) = w; } }
    }
};
struct EpiEO {
    static constexpr bool PERM = true, NEEDS_SYNC = false;
    bf16_t* EO;
    __device__ __forceinline__ void operator()(const f32x4 (&acc)[2][2][4][2], const Unit& u, int wr, int wc, int fr, int fq) const {
        const int b = u.pn >> 3, s0 = (u.pn & 7) * 256 + wc * 32 + 8 * fq, part = u.pm >> 1;
#pragma unroll
        for (int ai = 0; ai < 2; ++ai)
#pragma unroll
            for (int m = 0; m < 4; ++m) { const int d = (u.pm & 1) * BM + ai * HALF + wr * 64 + m * 16 + fr;
                bf16_t* rowp = EO + ((size_t)part * 2048 * 2048 + (size_t)(b * 512 + d) * 2048 + s0);
#pragma unroll
                for (int bj = 0; bj < 2; ++bj) { const f32x4 v0 = acc[ai][bj][m][0], v1 = acc[ai][bj][m][1];
                    u32x4 w; w.x = cvt_pk_bf16(v0[0], v0[1]); w.y = cvt_pk_bf16(v0[2], v0[3]); w.z = cvt_pk_bf16(v1[0], v1[1]); w.w = cvt_pk_bf16(v1[2], v1[3]);
                    *(u32x4*)(rowp + bj * HALF) = w; } }
    }
};
struct EpiDFT {
    static constexpr bool PERM = true, NEEDS_SYNC = false;
    bf16_t* YC; const float* fb; const float* u2048;
    __device__ __forceinline__ void operator()(const f32x4 (&acc)[2][2][4][2], const Unit& u, int wr, int wc, int fr, int fq) const {
        const int type = u.pm >> 3, b = u.pn >> 1, d0 = (u.pn & 1) * 256 + wc * 32 + 8 * fq;
        f32x4 bv[2][2], uv[2][2];
#pragma unroll
        for (int bj = 0; bj < 2; ++bj)
#pragma unroll
            for (int n = 0; n < 2; ++n) { bv[bj][n] = type ? (f32x4){0.f, 0.f, 0.f, 0.f} : *(const f32x4*)(fb + d0 + bj * HALF + 4 * n);
                                          uv[bj][n] = type ? (f32x4){0.f, 0.f, 0.f, 0.f} : *(const f32x4*)(u2048 + b * 512 + d0 + bj * HALF + 4 * n); }
        const float sg = type ? -1.f : 1.f;
#pragma unroll
        for (int ai = 0; ai < 2; ++ai)
#pragma unroll
            for (int m = 0; m < 4; ++m) { const int sp = (u.pm & 7) * BM + ai * HALF + wr * 64 + m * 16 + fr; const float par = (sp & 1) ? -1.f : 1.f;
                bf16_t* row1 = YC + ((size_t)(b * 4096 + sp) * 1536 + type * 512 + d0);
                bf16_t* row2 = YC + ((size_t)(b * 4096 + ((4096 - sp) & 4095)) * 1536 + type * 512 + d0);
#pragma unroll
                for (int bj = 0; bj < 2; ++bj) { const f32x4 t0 = acc[ai][bj][m][0], t1 = acc[ai][bj][m][1];
                    const f32x4 c0 = uv[bj][0] * par + bv[bj][0], c1 = uv[bj][1] * par + bv[bj][1];
                    const f32x4 v0 = t0 * sg + c0, v1 = t1 * sg + c1;
                    u32x4 w; w.x = cvt_pk_bf16(v0[0], v0[1]); w.y = cvt_pk_bf16(v0[2], v0[3]); w.z = cvt_pk_bf16(v1[0], v1[1]); w.w = cvt_pk_bf16(v1[2], v1[3]);
                    *(u32x4*)(row1 + bj * HALF) = w;
                    if (sp != 0) { const f32x4 x0 = t0 + c0, x1 = t1 + c1;
                        u32x4 w2; w2.x = cvt_pk_bf16(x0[0], x0[1]); w2.y = cvt_pk_bf16(x0[2], x0[3]); w2.z = cvt_pk_bf16(x1[0], x1[1]); w2.w = cvt_pk_bf16(x1[2], x1[3]);
                        *(u32x4*)(row2 + bj * HALF) = w2; } } }
    }
};
struct EpiResF32 {
    static constexpr bool PERM = false, NEEDS_SYNC = false;
    const float* base; float* out;
    __device__ __forceinline__ void operator()(const f32x4 (&acc)[2][2][4][2], const Unit& u, int wr, int wc, int fr, int fq) const {
        const int row0 = u.pm * BM + wr * 64 + fr, col0 = u.pn * BM + wc * 32 + 4 * fq;
#pragma unroll
        for (int ai = 0; ai < 2; ++ai)
#pragma unroll
            for (int m = 0; m < 4; ++m) { const size_t off = (size_t)(row0 + ai * HALF + m * 16) * 1024 + col0;
#pragma unroll
                for (int bj = 0; bj < 2; ++bj)
#pragma unroll
                    for (int n = 0; n < 2; ++n) { const f32x4 bs = *(const f32x4*)(base + off + bj * HALF + n * 16); *(f32x4*)(out + off + bj * HALF + n * 16) = bs + acc[ai][bj][m][n]; } }
    }
};

__device__ __forceinline__ float dpp_shr1(float old, float src) { return __builtin_bit_cast(float, __builtin_amdgcn_update_dpp(__builtin_bit_cast(int, old), __builtin_bit_cast(int, src), 0x111, 0xf, 0xf, false)); }
__device__ __forceinline__ float dpp_shl1(float old, float src) { return __builtin_bit_cast(float, __builtin_amdgcn_update_dpp(__builtin_bit_cast(int, old), __builtin_bit_cast(int, src), 0x101, 0xf, 0xf, false)); }
__device__ __forceinline__ float dpp_ror1(float src) { return __builtin_bit_cast(float, __builtin_amdgcn_update_dpp(0, __builtin_bit_cast(int, src), 0x121, 0xf, 0xf, false)); }
__device__ __forceinline__ float dpp_rol1(float src) { return __builtin_bit_cast(float, __builtin_amdgcn_update_dpp(0, __builtin_bit_cast(int, src), 0x12F, 0xf, 0xf, false)); }

struct EpiConvAct {
    static constexpr bool PERM = true, NEEDS_SYNC = true;
    bf16_t* ACT; const float* conv_w; const float* conv_b; PG8_LAS float* xch;
    __device__ __forceinline__ void operator()(const f32x4 (&acc)[2][2][4][2], const Unit& u, int wr, int wc, int fr, int fq) const {
        const int tc0 = wc * 32 + 8 * fq;
#pragma unroll
        for (int ai = 0; ai < 2; ++ai) { const int ch = 2 * ai + wr;
#pragma unroll
            for (int bj = 0; bj < 2; ++bj)
#pragma unroll
                for (int n = 0; n < 2; ++n) {
                    if (fr == 0)  *(PG8_LAS f32x4*)(xch + (ch * 2 + 0) * 256 + bj * HALF + tc0 + 4 * n) = acc[ai][bj][0][n];
                    if (fr == 15) *(PG8_LAS f32x4*)(xch + (ch * 2 + 1) * 256 + bj * HALF + tc0 + 4 * n) = acc[ai][bj][3][n]; } }
        asm volatile("s_waitcnt lgkmcnt(0)" ::: "memory"); __builtin_amdgcn_s_barrier(); asm volatile("" ::: "memory");
        const int jg = u.pn * HALF + tc0;
#pragma unroll
        for (int n = 0; n < 2; ++n) {
            f32x4 w0[2], w1[2], w2[2], cb[2];
#pragma unroll
            for (int bj = 0; bj < 2; ++bj) { const int ch = bj * DFF + jg + 4 * n;
                w0[bj] = *(const f32x4*)(conv_w + ch); w1[bj] = *(const f32x4*)(conv_w + NUP + ch); w2[bj] = *(const f32x4*)(conv_w + 2 * NUP + ch); cb[bj] = *(const f32x4*)(conv_b + ch); }
#pragma unroll
            for (int ai = 0; ai < 2; ++ai) { const int ch = 2 * ai + wr;
                f32x4 xup[2], xdn[2];
#pragma unroll
                for (int bj = 0; bj < 2; ++bj) {
                    xup[bj] = *(const PG8_LAS f32x4*)(xch + (((ch + 3) & 3) * 2 + 1) * 256 + bj * HALF + tc0 + 4 * n);
                    xdn[bj] = *(const PG8_LAS f32x4*)(xch + (((ch + 1) & 3) * 2 + 0) * 256 + bj * HALF + tc0 + 4 * n); }
#pragma unroll
                for (int m = 0; m < 4; ++m) {
                    const int tr = ai * HALF + wr * 64 + m * 16 + fr; const int g = u.pm * 254 - 1 + tr;
                    const bool has_up = (g & 4095) != 0, has_dn = (g & 4095) != 4095;
                    float cv[2][4];
#pragma unroll
                    for (int bj = 0; bj < 2; ++bj)
#pragma unroll
                        for (int e = 0; e < 4; ++e) {
                            const float cur = acc[ai][bj][m][n][e];
                            float up, dn;
                            if (m == 0) up = dpp_shr1(xup[bj][e], cur); else up = dpp_shr1(dpp_ror1(acc[ai][bj][m - 1][n][e]), cur);
                            if (m == 3) dn = dpp_shl1(xdn[bj][e], cur); else dn = dpp_shl1(dpp_rol1(acc[ai][bj][m + 1][n][e]), cur);
                            up = has_up ? up : 0.f; dn = has_dn ? dn : 0.f;
                            cv[bj][e] = w0[bj][e] * up + (w1[bj][e] * cur + (w2[bj][e] * dn + cb[bj][e]));
                        }
                    float a[4];
#pragma unroll
                    for (int e = 0; e < 4; ++e) { const float gt = cv[0][e]; const float sg = __builtin_amdgcn_rcpf(1.f + __builtin_amdgcn_exp2f(-LOG2E * gt)); a[e] = gt * sg * cv[1][e]; }
                    u32x2 w; w.x = cvt_pk_bf16(a[0], a[1]); w.y = cvt_pk_bf16(a[2], a[3]);
                    if (tr >= 1 && tr <= 254 && g < M) *(u32x2*)(ACT + (size_t)g * DFF + jg + 4 * n) = w;
                }
            }
        }
        asm volatile("s_waitcnt lgkmcnt(0)" ::: "memory"); __builtin_amdgcn_s_barrier(); asm volatile("" ::: "memory");
    }
};

template <class Epi, class Sched>
__device__ __forceinline__ void gemm_phase(PG8_LAS unsigned char* lds, const Gemm g, const Sched& S, const Epi& E) {
    const int tid = threadIdx.x, wid = __builtin_amdgcn_readfirstlane(tid >> 6), lane = tid & 63, wr = wid >> 2, wc = wid & 3, fr = lane & 15, fq = lane >> 4;
    const int K = g.K, nt = K / BK;
    unsigned voffA[2], voffB[2];
#pragma unroll
    for (int i = 0; i < 2; ++i) { int R, C; stage_rc(tid * 16 + i * 8192, R, C); const int Rb = Epi::PERM ? ((R & ~31) + perm32(R & 31)) : R;
        voffA[i] = (unsigned)(R * K + C) * 2u; voffB[i] = (unsigned)(Rb * K + C) * 2u; }
    const size_t kstep = (size_t)(BK * 2);
    const size_t hsA = g.hstepA, hsB = g.hstepB;
    const unsigned ldsw = (unsigned)wid * 1024u;
    const int aoff = lds_byte(wr * 64 + fr, fq * 8), boff = lds_byte(wc * 32 + fr, fq * 8);
#define PG8_SA(b, h) (((b) * 2 + (h)) * HTB)
#define PG8_SB(b, h) ((4 + (b) * 2 + (h)) * HTB)
#define PG8_STAGE(bufoff, gbase, voff) do { _Pragma("unroll") for (int _i = 0; _i < 2; ++_i) \
        __builtin_amdgcn_global_load_lds((const unsigned*)((const char*)(gbase) + (voff)[_i]), (PG8_LAS unsigned*)(lds + (bufoff) + ldsw + _i * 8192), 16, 0, 0); } while (0)
#define PG8_LDA(dst, b, h) do { _Pragma("unroll") for (int m = 0; m < 4; ++m) _Pragma("unroll") for (int k = 0; k < 2; ++k) dst[m][k] = *(const PG8_LAS bf16x8*)(lds + PG8_SA(b, h) + aoff + m * 2048 + k * 1024); } while (0)
#define PG8_LDB(dst, b, h) do { _Pragma("unroll") for (int n = 0; n < 2; ++n) _Pragma("unroll") for (int k = 0; k < 2; ++k) dst[n][k] = *(const PG8_LAS bf16x8*)(lds + PG8_SB(b, h) + boff + n * 2048 + k * 1024); } while (0)
#define PG8_MMA(ai, bj, At, Bt) do { __builtin_amdgcn_s_setprio(1); _Pragma("unroll") for (int m = 0; m < 4; ++m) _Pragma("unroll") for (int n = 0; n < 2; ++n) _Pragma("unroll") for (int k = 0; k < 2; ++k) \
        acc[ai][bj][m][n] = __builtin_amdgcn_mfma_f32_16x16x32_bf16(Bt[n][k], At[m][k], acc[ai][bj][m][n], 0, 0, 0); __builtin_amdgcn_s_setprio(0); } while (0)
#define PG8_WAIT_V(n) asm volatile("s_waitcnt vmcnt(" #n ")" ::: "memory")
#define PG8_WAIT_L(n) asm volatile("s_waitcnt lgkmcnt(" #n ")" ::: "memory")
#define PG8_BAR __builtin_amdgcn_s_barrier()
#define PG8_SCHED __builtin_amdgcn_sched_barrier(0)
    Unit cur, nxt; int ui = 0;
    if (!S.next(0, cur)) return;
    f32x4 acc[2][2][4][2];
#pragma unroll
    for (int a = 0; a < 2; ++a)
#pragma unroll
        for (int b = 0; b < 2; ++b)
#pragma unroll
            for (int m = 0; m < 4; ++m)
#pragma unroll
                for (int n = 0; n < 2; ++n) acc[a][b][m][n] = (f32x4){0.f, 0.f, 0.f, 0.f};
    bf16x8 At[4][2], B0[2][2], B1[2][2];
    const char* cA = (const char*)g.A + (size_t)cur.pm * g.tstepA; const char* cB = (const char*)g.Bt + (size_t)cur.pn * g.tstepB + (size_t)(cur.pm >> g.pmsh) * g.bpm;
    PG8_STAGE(PG8_SB(0, 0), cB, voffB); PG8_STAGE(PG8_SB(0, 1), cB + hsB, voffB); PG8_STAGE(PG8_SA(0, 0), cA, voffA); PG8_STAGE(PG8_SA(0, 1), cA + hsA, voffA);
    if (wr == 1) PG8_BAR;
    PG8_WAIT_V(2); PG8_BAR;
    PG8_STAGE(PG8_SB(1, 0), cB + kstep, voffB); PG8_STAGE(PG8_SA(1, 0), cA + kstep, voffA); PG8_STAGE(PG8_SB(1, 1), cB + hsB + kstep, voffB);
    PG8_WAIT_V(6); PG8_BAR;
    for (;;) {
        const bool has_next = S.next(ui + 1, nxt);
        const char* nA = has_next ? (const char*)g.A + (size_t)nxt.pm * g.tstepA : cA; const char* nB = has_next ? (const char*)g.Bt + (size_t)nxt.pn * g.tstepB + (size_t)(nxt.pm >> g.pmsh) * g.bpm : cB;
        for (int t = 0; t < nt; t += 2) {
            const bool last = (t == nt - 2);
            const char* a1 = cA + (size_t)(t + 1) * kstep;
            const char* a2 = last ? nA : cA + (size_t)(t + 2) * kstep; const char* b2 = last ? nB : cB + (size_t)(t + 2) * kstep;
            const char* a3 = a2 + kstep; const char* b3 = b2 + kstep;
            PG8_LDB(B0, 0, 0); PG8_LDB(B1, 0, 1); PG8_SCHED; PG8_LDA(At, 0, 0); PG8_STAGE(PG8_SA(1, 1), a1 + hsA, voffA);
            PG8_WAIT_V(8); PG8_WAIT_L(0); PG8_BAR; PG8_MMA(0, 0, At, B0); PG8_MMA(0, 1, At, B1); PG8_BAR; PG8_SCHED;
            PG8_LDA(At, 0, 1); PG8_STAGE(PG8_SB(0, 0), b2, voffB); PG8_STAGE(PG8_SB(0, 1), b2 + hsB, voffB); PG8_STAGE(PG8_SA(0, 0), a2, voffA);
            PG8_WAIT_V(8); PG8_WAIT_L(0); PG8_BAR; PG8_MMA(1, 0, At, B0); PG8_MMA(1, 1, At, B1); PG8_BAR; PG8_SCHED;
            PG8_LDB(B0, 1, 0); PG8_LDB(B1, 1, 1); PG8_SCHED; PG8_LDA(At, 1, 0); PG8_STAGE(PG8_SA(0, 1), a2 + hsA, voffA);
            PG8_WAIT_V(8); PG8_WAIT_L(0); PG8_BAR; PG8_MMA(0, 0, At, B0); PG8_MMA(0, 1, At, B1); PG8_BAR; PG8_SCHED;
            PG8_LDA(At, 1, 1); PG8_STAGE(PG8_SB(1, 0), b3, voffB); PG8_STAGE(PG8_SB(1, 1), b3 + hsB, voffB); PG8_STAGE(PG8_SA(1, 0), a3, voffA);
            PG8_WAIT_V(8); PG8_WAIT_L(0); PG8_BAR; PG8_MMA(1, 0, At, B0); PG8_MMA(1, 1, At, B1); PG8_BAR; PG8_SCHED;
        }
        if (wr == 0) PG8_BAR;
        E(acc, cur, wr, wc, fr, fq);
        if (!has_next) break;
#pragma unroll
        for (int a = 0; a < 2; ++a)
#pragma unroll
            for (int b = 0; b < 2; ++b)
#pragma unroll
                for (int m = 0; m < 4; ++m)
#pragma unroll
                    for (int n = 0; n < 2; ++n) acc[a][b][m][n] = (f32x4){0.f, 0.f, 0.f, 0.f};
        cur = nxt; cA = nA; cB = nB; ++ui;
        if (wr == 1) PG8_BAR;
    }
    PG8_WAIT_V(0);
    PG8_BAR;
#undef PG8_SA
#undef PG8_SB
#undef PG8_STAGE
#undef PG8_LDA
#undef PG8_LDB
#undef PG8_MMA
#undef PG8_WAIT_V
#undef PG8_WAIT_L
#undef PG8_BAR
#undef PG8_SCHED
}
}

namespace att {
using bf16 = __hip_bfloat16;
using bf16x8 = __attribute__((ext_vector_type(8))) short;
using s16x4  = __attribute__((ext_vector_type(4))) short;
using f32x16 = __attribute__((ext_vector_type(16))) float;
using f32x4  = __attribute__((ext_vector_type(4))) float;
using u32x4  = __attribute__((ext_vector_type(4))) unsigned;
constexpr int NW = 8, QBLK = 32, KVBLK = 64, LDK = 512;
constexpr size_t SHM_V = KVBLK * 128 * 2, SHM_K = KVBLK * 128 * 2;
constexpr int OFF_V = 0, OFF_K = 2 * (int)SHM_V, OFF_WS = OFF_K + 2 * (int)SHM_K, OFF_TB = OFF_WS + NW * 64 * 4, OFF_X = OFF_TB + 2304, XS = 132, X_FLOATS = 32 * XS;
constexpr int LDS_BYTES = OFF_X + 4 * X_FLOATS * 4;
constexpr float THRL = 8.f * LOG2E;
#define KSWZ(row, colB) ((row) * 256 + ((colB) ^ (((row) & 7) << 4)))
#define SBAR() __builtin_amdgcn_sched_barrier(0)
__device__ __forceinline__ int crow(int r, int hi) { return (r & 3) + 8 * (r >> 2) + 4 * hi; }
__device__ __forceinline__ unsigned cvtpk(float lo, float hi) { unsigned r; asm volatile("v_cvt_pk_bf16_f32 %0, %1, %2" : "=v"(r) : "v"(lo), "v"(hi)); return r; }
__device__ __forceinline__ int t5_bucket(int rel) {
    const int n = rel < 0 ? -rel : rel; int v;
    if (n < 8) v = n; else if (n < 12) v = 8; else if (n < 16) v = 9; else if (n < 23) v = 10; else if (n < 32) v = 11; else if (n < 46) v = 12; else if (n < 64) v = 13; else if (n < 91) v = 14; else v = 15;
    return (rel > 0 ? 16 : 0) + v;
}
__device__ __forceinline__ void partialSM(f32x16& p0, f32x16& p1, float& m_reg, float& mn, float& alpha) {
  float pmax = p0[0];
#pragma unroll
  for (int r = 1; r < 16; ++r) pmax = fmaxf(pmax, p0[r]);
#pragma unroll
  for (int r = 0; r < 16; ++r) pmax = fmaxf(pmax, p1[r]);
  { auto rr = __builtin_amdgcn_permlane32_swap(__float_as_uint(pmax), __float_as_uint(pmax), false, false);
    pmax = fmaxf(__uint_as_float(rr[0]), __uint_as_float(rr[1])); }
  if (__builtin_expect(__all(pmax - m_reg <= THRL), 1)) { mn = m_reg; alpha = 1.f; }
  else { mn = fmaxf(m_reg, pmax); alpha = __builtin_amdgcn_exp2f(m_reg - mn); m_reg = mn; }
#pragma unroll
  for (int r = 0; r < 16; ++r) p0[r] = p0[r] - mn;
#pragma unroll
  for (int r = 0; r < 16; ++r) p1[r] = p1[r] - mn;
#pragma unroll
  for (int r = 0; r < 16; ++r) p0[r] = __builtin_amdgcn_exp2f(p0[r]);
}
__device__ __forceinline__ void finishSM(f32x16& p0, f32x16& p1, float alpha, float& l_reg, bf16x8& pa0, bf16x8& pa1, bf16x8& pa2, bf16x8& pa3) {
#pragma unroll
  for (int r = 0; r < 16; ++r) p1[r] = __builtin_amdgcn_exp2f(p1[r]);
  float ps = 0;
#pragma unroll
  for (int r = 0; r < 16; ++r) ps += p0[r];
#pragma unroll
  for (int r = 0; r < 16; ++r) ps += p1[r];
  { auto rr = __builtin_amdgcn_permlane32_swap(__float_as_uint(ps), __float_as_uint(ps), false, false);
    ps = __uint_as_float(rr[0]) + __uint_as_float(rr[1]); }
  l_reg = l_reg * alpha + ps;
#define PK4(P, BASE, OUT) do { unsigned a0 = cvtpk(P[BASE + 0], P[BASE + 1]), a1 = cvtpk(P[BASE + 2], P[BASE + 3]);   \
    unsigned b0 = cvtpk(P[BASE + 4], P[BASE + 5]), b1 = cvtpk(P[BASE + 6], P[BASE + 7]);                              \
    auto r0 = __builtin_amdgcn_permlane32_swap(a0, b0, false, false); auto r1 = __builtin_amdgcn_permlane32_swap(a1, b1, false, false); \
    u32x4 w = {r0[0], r1[0], r0[1], r1[1]}; OUT = *reinterpret_cast<bf16x8*>(&w); } while (0)
  PK4(p0, 0, pa0); PK4(p0, 8, pa1); PK4(p1, 0, pa2); PK4(p1, 8, pa3);
#undef PK4
}
__device__ __forceinline__ void qkt(f32x16& p0, f32x16& p1, const bf16* Ks, const bf16x8* qr, int r32, int hi, int mp) {
#pragma unroll
  for (int d0 = 0; d0 < 4; ++d0) { int cb = (mp * 64 + d0 * 16 + hi * 8) * 2;
    bf16x8 b0 = *reinterpret_cast<const bf16x8*>((const char*)Ks + KSWZ(r32, cb));
    bf16x8 b1 = *reinterpret_cast<const bf16x8*>((const char*)Ks + KSWZ(32 + r32, cb));
    p0 = __builtin_amdgcn_mfma_f32_32x32x16_bf16(b0, qr[d0], p0, 0, 0, 0);
    p1 = __builtin_amdgcn_mfma_f32_32x32x16_bf16(b1, qr[d0], p1, 0, 0, 0); }
}
__device__ __forceinline__ void binit(f32x16& p0, f32x16& p1, const float* tb, int j, int qw0  , int qpos, int hi) {
  const int relmin = 64 * j - (qw0 + 31), relmax = 64 * j + 63 - qw0;
  if (relmax <= -128) { const float c = tb[0];
#pragma unroll
    for (int r = 0; r < 16; ++r) { p0[r] = c; p1[r] = c; } }
  else if (relmin >= 128) { const float c = tb[512];
#pragma unroll
    for (int r = 0; r < 16; ++r) { p0[r] = c; p1[r] = c; } }
  else { const float* t = tb + (64 * j - qpos + 256 + 4 * hi);
#pragma unroll
    for (int r = 0; r < 16; ++r) { p0[r] = t[(r & 3) + 8 * (r >> 2)]; p1[r] = t[32 + (r & 3) + 8 * (r >> 2)]; } }
}
__device__ __forceinline__ int v_st(int k, int c) { const int kk = (k & ~0xC) | ((k & 4) << 1) | ((k & 8) >> 1); return ((kk >> 3) * 4 + (c >> 5)) * 512 + ((kk & 7) * 32 + (c & 31)) * 2; }
__device__ __forceinline__ int v_rd_base(int lane) { return ((lane & 3) << 3) | (((lane >> 2) & 3) << 6) | (((lane >> 4) & 1) << 5) | (((lane >> 5) & 1) << 8); }
constexpr int v_rd_off(int d0, int ks, int half) { return d0 * 512 + ks * 4096 + half * 2048; }
template <int OFF> __device__ __forceinline__ s16x4 tr_read(int vb) {
  s16x4 r; asm volatile("ds_read_b64_tr_b16 %0, %1 offset:%2" : "=&v"(r) : "v"(vb), "i"(OFF) : "memory"); return r;
}
template <int D0> __device__ __forceinline__ void pv_one(f32x16& od, int vb, bf16x8 pa0, bf16x8 pa1, bf16x8 pa2, bf16x8 pa3) {
  const s16x4 l0 = tr_read<v_rd_off(D0, 0, 0)>(vb), h0 = tr_read<v_rd_off(D0, 0, 1)>(vb), l1 = tr_read<v_rd_off(D0, 1, 0)>(vb), h1 = tr_read<v_rd_off(D0, 1, 1)>(vb);
  const s16x4 l2 = tr_read<v_rd_off(D0, 2, 0)>(vb), h2 = tr_read<v_rd_off(D0, 2, 1)>(vb), l3 = tr_read<v_rd_off(D0, 3, 0)>(vb), h3 = tr_read<v_rd_off(D0, 3, 1)>(vb);
  asm volatile("s_waitcnt lgkmcnt(0)" ::: "memory"); SBAR();
#define PK(L, H) (bf16x8){L[0], L[1], L[2], L[3], H[0], H[1], H[2], H[3]}
  od = __builtin_amdgcn_mfma_f32_32x32x16_bf16(pa0, PK(l0, h0), od, 0, 0, 0);
  od = __builtin_amdgcn_mfma_f32_32x32x16_bf16(pa1, PK(l1, h1), od, 0, 0, 0);
  od = __builtin_amdgcn_mfma_f32_32x32x16_bf16(pa2, PK(l2, h2), od, 0, 0, 0);
  od = __builtin_amdgcn_mfma_f32_32x32x16_bf16(pa3, PK(l3, h3), od, 0, 0, 0);
#undef PK
}
__device__ __forceinline__ void pv_d0(f32x16* o, int vb, bf16x8 pa0, bf16x8 pa1, bf16x8 pa2, bf16x8 pa3) {
  pv_one<0>(o[0], vb, pa0, pa1, pa2, pa3); pv_one<1>(o[1], vb, pa0, pa1, pa2, pa3); pv_one<2>(o[2], vb, pa0, pa1, pa2, pa3); pv_one<3>(o[3], vb, pa0, pa1, pa2, pa3);
}

__device__ __forceinline__ void attn_unit(int b, int h, int qblk, const bf16* __restrict__ Q, const bf16* __restrict__ K, const bf16* __restrict__ V,
                                          unsigned short* __restrict__ YC, const float* __restrict__ rel_bias, const float* __restrict__ subln_g, float lam, char* lds) {
  const int tid = threadIdx.x, wid = __builtin_amdgcn_readfirstlane(tid >> 6), lane = tid & 63, r32 = lane & 31, hi = lane >> 5;
  const int qg = wid & 3, mp = wid >> 2;
  bf16* V_lds = (bf16*)(lds + OFF_V); bf16* K_lds = (bf16*)(lds + OFF_K);
  float* ws = (float*)(lds + OFF_WS) + wid * 64; float* li_l = ws; float* al_l = ws + 32;
  float* tb = (float*)(lds + OFF_TB);
  for (int i = tid; i < 513; i += 512) tb[i] = rel_bias[t5_bucket(i - 256) * 4 + h] * LOG2E;
  const long tok0 = (long)b * SEQ; const int q0 = qblk * 128, qw0 = q0 + qg * 32, qpos = qw0 + r32;
  float m_reg = -1e30f, l_reg = 0; f32x16 o[4] = {}; bf16x8 qr[4];
  const bf16* Qw = Q + (tok0 + qpos) * LDK + h * 128 + mp * 64 + hi * 8;
#pragma unroll
  for (int d0 = 0; d0 < 4; ++d0) qr[d0] = *reinterpret_cast<const bf16x8*>(Qw + d0 * 16);
  const bf16* Kh = K + tok0 * LDK + h * 128; const bf16* Vh = V + tok0 * LDK + h * 128;
  const int sr = tid >> 4, sc = (tid & 15) * 8, vst0 = v_st(sr, sc), vst1 = v_st(32 + sr, sc);
  const int vb0 = (int)(uintptr_t)V_lds + v_rd_base(lane); const unsigned voff = (unsigned)((sr * LDK + sc) * 2);
  struct { bf16x8 vs0, vs1, ks0, ks1; } sr_[1];
#define SLOAD(i, k0) do { const char* kb_ = (const char*)Kh + (size_t)(k0) * (LDK * 2); const char* vb_ = (const char*)Vh + (size_t)(k0) * (LDK * 2); \
    sr_[i].vs0 = *reinterpret_cast<const bf16x8*>(vb_ + voff); sr_[i].vs1 = *reinterpret_cast<const bf16x8*>(vb_ + 32 * LDK * 2 + voff); \
    sr_[i].ks0 = *reinterpret_cast<const bf16x8*>(kb_ + voff); sr_[i].ks1 = *reinterpret_cast<const bf16x8*>(kb_ + 32 * LDK * 2 + voff); } while (0)
#define SWRITE(bb, i) do { *(bf16x8*)((char*)V_lds + (bb) * SHM_V + vst0) = sr_[i].vs0;          \
    *(bf16x8*)((char*)V_lds + (bb) * SHM_V + vst1) = sr_[i].vs1; int kc = sc * 2;               \
    *(bf16x8*)((char*)K_lds + (bb) * SHM_K + KSWZ(sr, kc)) = sr_[i].ks0;                       \
    *(bf16x8*)((char*)K_lds + (bb) * SHM_K + KSWZ(32 + sr, kc)) = sr_[i].ks1; } while (0)
#define SWAIT() asm volatile("s_waitcnt vmcnt(0)" ::: "memory")
#define RESC(a) do { if (__any((a) < 1.f)) { if (hi == 0) al_l[r32] = (a); asm volatile("s_waitcnt lgkmcnt(0)" ::: "memory"); \
    _Pragma("unroll") for (int d = 0; d < 4; ++d) _Pragma("unroll") for (int r = 0; r < 16; ++r) o[d][r] *= al_l[crow(r, hi)]; } } while (0)
  f32x16 pA0, pA1, pB0, pB1; float mnA, mnB, alA, alB; bf16x8 pa0, pa1, pa2, pa3; constexpr int NT = SEQ / KVBLK;
  constexpr int SE = 0, SO = 0;
  SLOAD(SE, 0); asm volatile("s_waitcnt vmcnt(0)" ::: "memory"); SWRITE(0, SE); __syncthreads();
  binit(pA0, pA1, tb, 0, qw0, qpos, hi);
  qkt(pA0, pA1, K_lds, qr, r32, hi, mp); partialSM(pA0, pA1, m_reg, mnA, alA);
  SLOAD(SO, KVBLK);
  SWAIT(); SWRITE(1, SO); __syncthreads();
  for (int j = 1; j + 1 < NT; j += 2) {
    binit(pB0, pB1, tb, j, qw0, qpos, hi);
    SBAR(); qkt(pB0, pB1, (bf16*)((char*)K_lds + SHM_K), qr, r32, hi, mp);
    finishSM(pA0, pA1, alA, l_reg, pa0, pa1, pa2, pa3); SBAR();
    SLOAD(SO, (j + 1) * KVBLK); SBAR();
    pv_d0(o, vb0, pa0, pa1, pa2, pa3); partialSM(pB0, pB1, m_reg, mnB, alB);
    __syncthreads(); SWAIT(); SWRITE(0, SE);
    RESC(alB); __syncthreads();
    binit(pA0, pA1, tb, j + 1, qw0, qpos, hi);
    SBAR(); qkt(pA0, pA1, K_lds, qr, r32, hi, mp);
    finishSM(pB0, pB1, alB, l_reg, pa0, pa1, pa2, pa3); SBAR();
    SLOAD(SE, (j + 2) * KVBLK); SBAR();
    pv_d0(o, vb0 + (int)SHM_V, pa0, pa1, pa2, pa3); partialSM(pA0, pA1, m_reg, mnA, alA);
    __syncthreads(); SWAIT(); SWRITE(1, SO);
    RESC(alA); __syncthreads();
  }
  binit(pB0, pB1, tb, NT - 1, qw0, qpos, hi);
  SBAR(); qkt(pB0, pB1, (bf16*)((char*)K_lds + SHM_K), qr, r32, hi, mp);
  finishSM(pA0, pA1, alA, l_reg, pa0, pa1, pa2, pa3); SBAR();
  pv_d0(o, vb0, pa0, pa1, pa2, pa3); partialSM(pB0, pB1, m_reg, mnB, alB);
  __syncthreads(); RESC(alB);
  finishSM(pB0, pB1, alB, l_reg, pa0, pa1, pa2, pa3); SBAR();
  pv_d0(o, vb0 + (int)SHM_V, pa0, pa1, pa2, pa3);
  if (hi == 0) li_l[r32] = l_reg; asm volatile("s_waitcnt lgkmcnt(0)" ::: "memory");
  float rli[16]; const float scm = (mp == 0) ? 1.f : lam;
#pragma unroll
  for (int r = 0; r < 16; ++r) rli[r] = scm * __builtin_amdgcn_rcpf(li_l[crow(r, hi)]);
  float* X = (float*)(lds + OFF_X) + qg * X_FLOATS;
  if (mp == 1) {
#pragma unroll
    for (int r = 0; r < 16; ++r)
#pragma unroll
      for (int d0 = 0; d0 < 4; ++d0) X[crow(r, hi) * XS + d0 * 32 + r32] = o[d0][r] * rli[r];
  }
  __syncthreads();
  if (mp == 0) {
#pragma unroll
    for (int r = 0; r < 16; ++r)
#pragma unroll
      for (int d0 = 0; d0 < 4; ++d0) { float* p = &X[crow(r, hi) * XS + d0 * 32 + r32]; *p = o[d0][r] * rli[r] - *p; }
    asm volatile("s_waitcnt lgkmcnt(0)" ::: "memory");
    const int row = lane >> 1, hf = lane & 1;
    f32x4 v[16]; float ss = 0.f;
#pragma unroll
    for (int i = 0; i < 16; ++i) { v[i] = *(const f32x4*)&X[row * XS + hf * 64 + i * 4]; ss += (v[i][0] * v[i][0] + v[i][1] * v[i][1]) + (v[i][2] * v[i][2] + v[i][3] * v[i][3]); }
    ss += __shfl_xor(ss, 1);
    const float rs = 0.8f / sqrtf(ss * (1.f / 128.f) + EPS);
    unsigned short* dst = YC + (size_t)(tok0 + qw0 + row) * 1536 + 1024 + h * 128 + hf * 64;
#pragma unroll
    for (int i = 0; i < 8; ++i) { const f32x4 g0 = *(const f32x4*)(subln_g + hf * 64 + i * 8), g1 = *(const f32x4*)(subln_g + hf * 64 + i * 8 + 4);
      const f32x4 a = v[2 * i] * g0 * rs, c = v[2 * i + 1] * g1 * rs;
      u32x4 w = {cvtpk(a[0], a[1]), cvtpk(a[2], a[3]), cvtpk(c[0], c[1]), cvtpk(c[2], c[3])}; *(u32x4*)(dst + i * 8) = w; }
  }
  __syncthreads();
#undef SLOAD
#undef SWRITE
#undef SWAIT
#undef RESC
}
#undef SBAR
}

constexpr int NWAVES = 8;
constexpr size_t MiB = 1u << 20;
constexpr size_t WS_CTL = 0, CTL_ZERO_BYTES = 64 * 1024;
constexpr size_t WS_G = 1 * MiB;
constexpr size_t WS_U2048 = 1 * MiB + 768 * 1024;
constexpr size_t WS_WQKV = 2 * MiB;
constexpr size_t WS_WF = 5 * MiB;
constexpr size_t WS_WO = 7 * MiB;
constexpr size_t WS_WUP = 10 * MiB;
constexpr size_t WS_WD = 21 * MiB;
constexpr size_t WS_XN = 27 * MiB;
constexpr int XN_ROWS = 1 + M + 129;
constexpr size_t WS_Q = 60 * MiB, WS_K = 76 * MiB, WS_V = 92 * MiB;
constexpr size_t WS_HE = 108 * MiB;
constexpr size_t WS_EO = 140 * MiB;
constexpr size_t WS_DM = 156 * MiB;
constexpr size_t WS_YC = 172 * MiB;
constexpr size_t WS_ACT = 60 * MiB;
constexpr size_t WS_END = 220 * MiB;
static_assert(WS_XN + (size_t)XN_ROWS * 2048 <= WS_Q && WS_ACT + (size_t)M * DFF * 2 <= WS_DM && WS_YC + (size_t)M * 1536 * 2 <= WS_END, "ws map");
constexpr int CW_TMO = 0, CW_BAR = 4096;

constexpr int RING_OFF = 0, RING_BYTES = 131072;
constexpr int XCH_OFF = RING_BYTES;
constexpr int LDSCTL_OFF = 147456, MISC_OFF = LDSCTL_OFF + 320;
constexpr int LDS_BYTES = LDSCTL_OFF + 1024;
static_assert(att::LDS_BYTES <= LDSCTL_OFF && XCH_OFF + 8192 <= LDSCTL_OFF, "LDS map");

#define GAS __attribute__((address_space(1)))
#define LAS __attribute__((address_space(3)))
typedef unsigned short bf16;
typedef unsigned v4u __attribute__((ext_vector_type(4)));
typedef float f32x4 __attribute__((ext_vector_type(4)));
typedef GAS unsigned gu32;
#define RLX_AGENT __ATOMIC_RELAXED, __HIP_MEMORY_SCOPE_AGENT
#define LDS_WAIT() asm volatile("s_waitcnt lgkmcnt(0)" ::: "memory")
#define VM_WAIT() asm volatile("s_waitcnt vmcnt(0)" ::: "memory")
__device__ __forceinline__ unsigned f2bf(float f) { unsigned u = __builtin_bit_cast(unsigned, f); return (u + 0x7fffu + ((u >> 16) & 1u)) >> 16; }
__device__ __forceinline__ unsigned pk2(float lo, float hi) { return f2bf(lo) | (f2bf(hi) << 16); }

#define XB_TMO      128
#define XB_XCNT(j)  (256  + 64 * (j))
#define XB_XSUB(j)  (1280 + 64 * (j))
#define XB_XGEN(j)  (2304 + 64 * (j))
#define XB_TOP      3328
#define XB_TOPGEN   3392
#define XCD_BAR_WORDS 3456
#define XB_SPIN_CAP (1u << 22)
__device__ __forceinline__ unsigned xb_ld(unsigned* p)              { return __hip_atomic_load(p, __ATOMIC_RELAXED, __HIP_MEMORY_SCOPE_AGENT); }
__device__ __forceinline__ unsigned xb_add(unsigned* p, unsigned v) { return __hip_atomic_fetch_add(p, v, __ATOMIC_RELAXED, __HIP_MEMORY_SCOPE_AGENT); }
__device__ __forceinline__ unsigned xb_xcc_id() { return (unsigned)__builtin_amdgcn_s_getreg((3 << 11) | 20) & 0xFu; }
#define XB_SPIN(cond, bar) do { unsigned _sp = 0; while (cond) { __builtin_amdgcn_s_sleep(1); \
    if ((++_sp & 255u) == 0u) { if (xb_ld(&(bar)[XB_TMO])) break; if (_sp > XB_SPIN_CAP) { atomicAdd(&(bar)[XB_TMO], 1u); break; } } } } while (0)
struct XcdBarrier { unsigned* bar; unsigned x; volatile LAS unsigned* st; };
__device__ __forceinline__ XcdBarrier xcd_barrier_post(unsigned* bar, volatile LAS unsigned* st) {
    XcdBarrier b; b.bar = bar; b.x = xb_xcc_id(); b.st = st;
    if (threadIdx.x == 0) (void)xb_add(&bar[XB_XCNT(b.x)], 1u);
    return b;
}
__device__ __forceinline__ void xcd_barrier_complete(unsigned* bar, unsigned x, unsigned& nloc, unsigned& nx) {
    const unsigned G = gridDim.x * gridDim.y * gridDim.z;
    unsigned sum, cnt, mine, sp = 0u;
    for (;;) {
        sum = 0u; cnt = 0u; mine = 0u;
#pragma unroll
        for (unsigned j = 0; j < 16; ++j) { const unsigned c = xb_ld(&bar[XB_XCNT(j)]); sum += c; cnt += (c > 0u) ? 1u : 0u; mine = (j == x) ? c : mine; }
        if (sum == G) break;
        __builtin_amdgcn_s_sleep(1);
        if ((++sp & 255u) == 0u) { if (xb_ld(&bar[XB_TMO])) break; if (sp > XB_SPIN_CAP) { atomicAdd(&bar[XB_TMO], 1u); break; } }
    }
    nloc = mine > 0u ? mine : 1u; nx = cnt > 0u ? cnt : 1u;
}
__device__ __forceinline__ void xcd_barrier(const XcdBarrier& b) {
    asm volatile("s_waitcnt vmcnt(0)" ::: "memory");
    __syncthreads();
    if (threadIdx.x == 0) {
        unsigned* bar = b.bar;
        __builtin_amdgcn_s_waitcnt(0);
        unsigned nloc = b.st[0], nx = b.st[1];
        if (nloc == 0u) { xcd_barrier_complete(bar, b.x, nloc, nx); b.st[0] = nloc; b.st[1] = nx; }
        const unsigned old = xb_add(&bar[XB_XSUB(b.x)], 1u);
        const unsigned gen = old / nloc;
        if (old + 1u == (gen + 1u) * nloc) {
            __builtin_amdgcn_fence(__ATOMIC_RELEASE, "agent");
            asm volatile("s_waitcnt vmcnt(0)" ::: "memory");
            const unsigned og = xb_add(&bar[XB_TOP], 1u);
            const unsigned tg = og / nx;
            if (og + 1u == (tg + 1u) * nx) xb_add(&bar[XB_TOPGEN], 1u);
            else XB_SPIN(xb_ld(&bar[XB_TOPGEN]) == tg, bar);
            __builtin_amdgcn_fence(__ATOMIC_ACQUIRE, "agent");
            xb_add(&bar[XB_XGEN(b.x)], 1u);
            asm volatile("s_waitcnt vmcnt(0)" ::: "memory");
        } else {
            XB_SPIN(xb_ld(&bar[XB_XGEN(b.x)]) == gen, bar);
            __builtin_amdgcn_fence(__ATOMIC_ACQUIRE, "agent");
            asm volatile("s_waitcnt vmcnt(0)" ::: "memory");
        }
    }
    __syncthreads();
}

struct Frame {
    LAS unsigned char* lds;
    volatile LAS unsigned* MISC;
    gu32* ctl;
    int tid, lane, wave, vcu, G;
};
__device__ __forceinline__ float wave_sum(float v) {
#pragma unroll
    for (int o = 1; o < 64; o <<= 1) v += __shfl_xor(v, o);
    return v;
}
__device__ __forceinline__ void p0_transpose_item(const float* W, int ldw, bf16* WT, int ldt, LAS float* scr, int kb, int nb, int lane) {
    const int k0 = 64 * kb, n0 = 32 * nb;
#pragma unroll 8
    for (int i = 0; i < 32; ++i) { const int kk = 2 * i + (lane >> 5); scr[kk * 33 + (lane & 31)] = W[(size_t)(k0 + kk) * ldw + n0 + (lane & 31)]; }
    LDS_WAIT(); asm volatile("" ::: "memory");
    const int c = lane & 7;
#pragma unroll
    for (int j = 0; j < 4; ++j) { const int n = (lane >> 3) + 8 * j; const LAS float* s = scr + (8 * c) * 33 + n;
        v4u o; o.x = pk2(s[0 * 33], s[1 * 33]); o.y = pk2(s[2 * 33], s[3 * 33]); o.z = pk2(s[4 * 33], s[5 * 33]); o.w = pk2(s[6 * 33], s[7 * 33]);
        *(GAS v4u*)(WT + (size_t)(n0 + n) * ldt + k0 + 8 * c) = o; }
    LDS_WAIT(); asm volatile("" ::: "memory");
}
__device__ __forceinline__ void rms_row_to_bf16(int lane, const float* xrow, const float* g, bf16* orow) {
    const GAS f32x4* xr = (const GAS f32x4*)xrow + lane; const GAS f32x4* gr = (const GAS f32x4*)g + lane;
    f32x4 v[4]; float s = 0.f;
#pragma unroll
    for (int j = 0; j < 4; ++j) { v[j] = xr[64 * j]; s += (v[j].x * v[j].x + v[j].y * v[j].y) + (v[j].z * v[j].z + v[j].w * v[j].w); }
    const float rstd = 1.f / sqrtf(wave_sum(s) * (1.f / D) + EPS);
    GAS unsigned long long* o8 = (GAS unsigned long long*)orow + lane;
#pragma unroll
    for (int j = 0; j < 4; ++j) { const f32x4 gg = gr[64 * j];
        o8[64 * j] = (unsigned long long)pk2(v[j].x * rstd * gg.x, v[j].y * rstd * gg.y) | ((unsigned long long)pk2(v[j].z * rstd * gg.z, v[j].w * rstd * gg.w) << 32); }
}
__device__ __forceinline__ void rms_row_f32(int lane, const float* xrow, const float* g, float* orow) {
    const GAS f32x4* xr = (const GAS f32x4*)xrow + lane; const GAS f32x4* gr = (const GAS f32x4*)g + lane;
    f32x4 v[4]; float s = 0.f;
#pragma unroll
    for (int j = 0; j < 4; ++j) { v[j] = xr[64 * j]; s += (v[j].x * v[j].x + v[j].y * v[j].y) + (v[j].z * v[j].z + v[j].w * v[j].w); }
    const float rstd = 1.f / sqrtf(wave_sum(s) * (1.f / D) + EPS);
    GAS f32x4* o = (GAS f32x4*)orow + lane;
#pragma unroll
    for (int j = 0; j < 4; ++j) o[64 * j] = v[j] * rstd * gr[64 * j];
}

struct Args { const float* in[18]; float* out; unsigned char* ws; int ph_lo, ph_hi, li, pad; };

__global__ void __launch_bounds__(NWAVES * 64, 2) enc_fwd(Args args) {
    extern __shared__ __attribute__((aligned(16))) unsigned char lds[];
    Frame F;
    F.lds = (LAS unsigned char*)lds;
    F.MISC = (volatile LAS unsigned*)(F.lds + MISC_OFF);
    F.tid = threadIdx.x; F.lane = F.tid & 63; F.wave = __builtin_amdgcn_readfirstlane(F.tid >> 6);
    F.G = gridDim.x; { const int bx = blockIdx.x; F.vcu = (F.G % 8 == 0) ? (bx % 8) * (F.G / 8) + bx / 8 : bx; }
    unsigned char* ws = args.ws;
    F.ctl = (gu32*)(ws + WS_CTL);
    const float* x = args.in[0]; const float* norm_mix_g = args.in[1]; const float* w_in = args.in[2]; const float* fourier_w = args.in[3]; const float* fourier_b = args.in[4];
    const float* lq1 = args.in[5]; const float* lk1 = args.in[6]; const float* lq2 = args.in[7]; const float* lk2 = args.in[8]; const float* subln_g = args.in[9];
    const float* rel_bias = args.in[10]; const float* w_out = args.in[11]; const float* norm_ffn_g = args.in[12]; const float* w_up = args.in[13];
    const float* conv_w = args.in[14]; const float* conv_b = args.in[15]; const float* w_down = args.in[16]; const float* norm_final_g = args.in[17];
    float* out = args.out;
    float* Gt = (float*)(ws + WS_G); float* U2048 = (float*)(ws + WS_U2048);
    bf16* Wqkv_t = (bf16*)(ws + WS_WQKV); bf16* Wf_t = (bf16*)(ws + WS_WF); bf16* Wo_t = (bf16*)(ws + WS_WO); bf16* Wup_t = (bf16*)(ws + WS_WUP); bf16* Wd_t = (bf16*)(ws + WS_WD);
    bf16* XN = (bf16*)(ws + WS_XN); bf16* Qb = (bf16*)(ws + WS_Q); bf16* Kb = (bf16*)(ws + WS_K); bf16* Vb = (bf16*)(ws + WS_V);
    bf16* HE = (bf16*)(ws + WS_HE); bf16* EO = (bf16*)(ws + WS_EO); bf16* DM = (bf16*)(ws + WS_DM); bf16* YC = (bf16*)(ws + WS_YC); bf16* ACT = (bf16*)(ws + WS_ACT);

    for (int u = F.tid; u < (LDS_BYTES - LDSCTL_OFF) / 4; u += NWAVES * 64) ((LAS unsigned*)(F.lds + LDSCTL_OFF))[u] = 0u;
    __syncthreads();
    XcdBarrier bar; bar.bar = (unsigned*)(F.ctl + CW_BAR); bar.x = 0; bar.st = nullptr;
    if (MK_N_LAUNCHES == 1) bar = xcd_barrier_post((unsigned*)(F.ctl + CW_BAR), F.MISC + 8);
#define GRID_BAR() do { if (MK_N_LAUNCHES == 1) xcd_barrier(bar); } while (0)
    const int lo = args.ph_lo, hi = args.ph_hi;
#ifndef PH_MASK
#define PH_MASK 0x3ff
#endif
#define IN(k) (((PH_MASK >> (k)) & 1) && lo <= (k) && (k) < hi)
#define BOTH(k) (IN(k) && IN((k) + 1))
#ifndef PROBE_DUP
#define PROBE_DUP -1
#endif
#define REP(k) for (int rep_ = 0; rep_ < ((PROBE_DUP == (k)) ? 2 : 1); ++rep_)
    const int gw = F.vcu * NWAVES + F.wave, NGW = F.G * NWAVES;
    const int gt = blockIdx.x * (NWAVES * 64) + F.tid, NGT = F.G * NWAVES * 64;

    if (IN(0)) { REP(0) {
        { LAS float* ct = (LAS float*)(F.lds + RING_OFF);
          __syncthreads();
          if (F.tid < 128) ct[F.tid] = cospif((float)F.tid * (1.f / 64.f));
          __syncthreads();
          for (int idx = gt; idx < 2 * 4 * 128 * 128; idx += NGT) {
              const int d = idx & 127, c = (idx >> 7) & 127, g = (idx >> 14) & 3, part = idx >> 16;
              const float* wg = fourier_w + (size_t)g * 16384 + d; float s = 0.f;
              for (int cp = 0; cp < 128; ++cp) { const int mm = (c * cp) & 127; const float t = part == 0 ? ct[mm] : ct[(mm - 32) & 127]; s += t * wg[cp * 128]; }
              Gt[idx] = s * 0.08838834764831845f;
          }
          __syncthreads(); }
        { LAS float* scr = (LAS float*)(F.lds + RING_OFF + F.wave * 16384);
          constexpr int I_QKV = 16 * 48, I_O = 3 * 8 * 32, I_UP = 16 * 176, I_D = 44 * 32, NITEMS = I_QKV + I_O + I_UP + I_D;
          for (int it = gw; it < NITEMS; it += NGW) {
              int r = it;
              if (r < I_QKV) { p0_transpose_item(w_in + 512, 2048, Wqkv_t, 1024, scr, r / 48, r % 48, F.lane); continue; } r -= I_QKV;
              if (r < I_O) { const int blk = r / 256, q = r % 256;
                  p0_transpose_item(w_out + (size_t)(blk == 2 ? 512 : 0) * 1024, 1024, Wo_t + blk * 512, 1536, scr, q / 32, q % 32, F.lane); continue; } r -= I_O;
              if (r < I_UP) { p0_transpose_item(w_up, NUP, Wup_t, 1024, scr, r / 176, r % 176, F.lane); continue; } r -= I_UP;
              p0_transpose_item(w_down, 1024, Wd_t, DFF, scr, r / 32, r % 32, F.lane);
          } }
        for (int it = gw; it < 4 * 2048; it += NGW) {
            const int b = it >> 11, s = it & 2047; const int r1 = b * SEQ + s, r2 = b * SEQ + (s == 0 ? 2048 : SEQ - s);
            const GAS f32x4* x1 = (const GAS f32x4*)(x + (size_t)r1 * D) + F.lane; const GAS f32x4* x2 = (const GAS f32x4*)(x + (size_t)r2 * D) + F.lane;
            const GAS f32x4* gr = (const GAS f32x4*)norm_mix_g + F.lane;
            f32x4 v1[4], v2[4]; float s1 = 0.f, s2 = 0.f;
#pragma unroll
            for (int j = 0; j < 4; ++j) { v1[j] = x1[64 * j]; v2[j] = x2[64 * j];
                s1 += (v1[j].x * v1[j].x + v1[j].y * v1[j].y) + (v1[j].z * v1[j].z + v1[j].w * v1[j].w); s2 += (v2[j].x * v2[j].x + v2[j].y * v2[j].y) + (v2[j].z * v2[j].z + v2[j].w * v2[j].w); }
            const float rs1 = 1.f / sqrtf(wave_sum(s1) * (1.f / D) + EPS), rs2 = 1.f / sqrtf(wave_sum(s2) * (1.f / D) + EPS);
            GAS unsigned long long* o1 = (GAS unsigned long long*)(XN + (size_t)(r1 + 1) * D) + F.lane; GAS unsigned long long* o2 = (GAS unsigned long long*)(XN + (size_t)(r2 + 1) * D) + F.lane;
            GAS unsigned long long* oe = (GAS unsigned long long*)(HE + (size_t)(b * 2048 + s) * D) + F.lane; GAS unsigned long long* oo = (GAS unsigned long long*)(HE + (size_t)(8192 + b * 2048 + s) * D) + F.lane;
#pragma unroll
            for (int j = 0; j < 4; ++j) { const f32x4 gg = gr[64 * j]; const f32x4 a = v1[j] * rs1 * gg, c = v2[j] * rs2 * gg;
                o1[64 * j] = (unsigned long long)pk2(a.x, a.y) | ((unsigned long long)pk2(a.z, a.w) << 32);
                o2[64 * j] = (unsigned long long)pk2(c.x, c.y) | ((unsigned long long)pk2(c.z, c.w) << 32);
                const f32x4 e = (s == 0) ? a : a + c, o = (s == 0) ? (f32x4){0.f, 0.f, 0.f, 0.f} : a - c;
                oe[64 * j] = (unsigned long long)pk2(e.x, e.y) | ((unsigned long long)pk2(e.z, e.w) << 32);
                oo[64 * j] = (unsigned long long)pk2(o.x, o.y) | ((unsigned long long)pk2(o.z, o.w) << 32); }
        }
        for (int idx = gt; idx < 130 * 128; idx += NGT) { const int r = idx >> 7, c = idx & 127; const int row = (r == 0) ? 0 : (M + r);
            *(GAS v4u*)(XN + (size_t)row * D + c * 8) = (v4u){0u, 0u, 0u, 0u}; }
        { __syncthreads();
          LAS float* ct = (LAS float*)(F.lds + RING_OFF);
          for (int i = F.tid; i < 4096; i += NWAVES * 64) ct[i] = cospif((float)i * (1.f / 2048.f)) * (1.f / 64.f);
          __syncthreads();
          for (int idx = gt; idx < 2 * 2048 * 256; idx += NGT) {
              const int type = idx >> 19, sp = (idx >> 8) & 2047, s0 = (idx & 255) * 8;
              float v[8];
#pragma unroll
              for (int e = 0; e < 8; ++e) v[e] = ct[(sp * (s0 + e) - type * 1024) & 4095];
              *(GAS v4u*)(DM + (size_t)type * 2048 * 2048 + (size_t)sp * 2048 + s0) = (v4u){pk2(v[0], v[1]), pk2(v[2], v[3]), pk2(v[4], v[5]), pk2(v[6], v[7])};
          }
          __syncthreads(); } }
        if (BOTH(0)) GRID_BAR();
    }
    if (IN(1)) {
        LAS float* wl = (LAS float*)(F.lds + RING_OFF);
        for (int item = blockIdx.x; item < 128; item += F.G) {
            const int part = item >> 6, g = (item >> 4) & 3, kb = item & 15;
            __syncthreads();
            for (int i = F.tid; i < 64 * 32; i += NWAVES * 64) { const int kk = i >> 5, c4 = (i & 31) * 4;
                *(LAS f32x4*)(wl + kk * 128 + c4) = *(const f32x4*)(w_in + (size_t)(kb * 64 + kk) * 2048 + g * 128 + c4); }
            __syncthreads();
            const int d = F.tid & 127, kq = F.tid >> 7;
            const float* Gp = Gt + (size_t)(part * 4 + g) * 16384 + d;
            float acc[16];
#pragma unroll
            for (int j = 0; j < 16; ++j) acc[j] = 0.f;
            for (int c4 = 0; c4 < 128; c4 += 4) {
                const float g0 = Gp[(c4 + 0) * 128], g1 = Gp[(c4 + 1) * 128], g2 = Gp[(c4 + 2) * 128], g3 = Gp[(c4 + 3) * 128];
#pragma unroll
                for (int j = 0; j < 16; ++j) { const f32x4 w = *(const LAS f32x4*)(wl + (kq * 16 + j) * 128 + c4); acc[j] += (w.x * g0 + w.y * g1) + (w.z * g2 + w.w * g3); }
            }
            bf16* dst = Wf_t + (size_t)(part * 512 + g * 128 + d) * 1024 + kb * 64 + kq * 16;
            *(GAS v4u*)(dst) = (v4u){pk2(acc[0], acc[1]), pk2(acc[2], acc[3]), pk2(acc[4], acc[5]), pk2(acc[6], acc[7])};
            *(GAS v4u*)(dst + 8) = (v4u){pk2(acc[8], acc[9]), pk2(acc[10], acc[11]), pk2(acc[12], acc[13]), pk2(acc[14], acc[15])};
        }
        __syncthreads();
        if (BOTH(1)) GRID_BAR();
    }
    if (IN(2)) {
        { pg8::Gemm g{XN + D, Wqkv_t, D, (size_t)256 * D * 2, (size_t)128 * D * 2, (size_t)256 * D * 2, (size_t)128 * D * 2, 0, 0};
          pg8::StaticOrder S; S.init(M / 256, 1536 / 256, F.G, (int)blockIdx.x);
          pg8::EpiQKV E{Qb, (size_t)(WS_K - WS_Q) / 2, 0.125f * LOG2E};
          pg8::gemm_phase<pg8::EpiQKV, pg8::StaticOrder>(F.lds + RING_OFF, g, S, E); }
        {
          pg8::Gemm g{Wf_t, HE, D, (size_t)256 * D * 2, (size_t)128 * D * 2, (size_t)256 * D * 2, (size_t)128 * D * 2, 1, (size_t)8192 * D * 2};
          pg8::StaticOrder S; S.init(4, 32, F.G, (int)blockIdx.x);
          pg8::EpiEO E{EO};
          pg8::gemm_phase<pg8::EpiEO, pg8::StaticOrder>(F.lds + RING_OFF, g, S, E); }
        for (int it = gw; it < 4 * 512; it += NGW) { const int b = it >> 9, d = it & 511;
            const v4u wa = *(const GAS v4u*)(Wf_t + (size_t)d * D + F.lane * 16), wb = *(const GAS v4u*)(Wf_t + (size_t)d * D + F.lane * 16 + 8);
            const v4u xa = *(const GAS v4u*)(XN + (size_t)(b * SEQ + 2048 + 1) * D + F.lane * 16), xb = *(const GAS v4u*)(XN + (size_t)(b * SEQ + 2048 + 1) * D + F.lane * 16 + 8);
            float sacc = 0.f;
#pragma unroll
            for (int e = 0; e < 4; ++e) { sacc += __uint_as_float(wa[e] << 16) * __uint_as_float(xa[e] << 16) + __uint_as_float(wa[e] & 0xffff0000u) * __uint_as_float(xa[e] & 0xffff0000u);
                                          sacc += __uint_as_float(wb[e] << 16) * __uint_as_float(xb[e] << 16) + __uint_as_float(wb[e] & 0xffff0000u) * __uint_as_float(xb[e] & 0xffff0000u); }
            sacc = wave_sum(sacc);
            if (F.lane == 0) U2048[it] = sacc * (1.f / 64.f); }
        if (BOTH(2)) GRID_BAR();
    }
    if (IN(3)) {
        for (int it = gw; it < 4 * 512; it += NGW) { const int b = it >> 9, d = it & 511; const bf16* er = EO + (size_t)it * 2048 + F.lane * 8;
            float sacc = 0.f;
#pragma unroll
            for (int i = 0; i < 4; ++i) { const v4u w = *(const GAS v4u*)(er + i * 512);
#pragma unroll
                for (int e = 0; e < 4; ++e) sacc += __uint_as_float(w[e] << 16) - __uint_as_float(w[e] & 0xffff0000u); }
            sacc = wave_sum(sacc);
            if (F.lane == 0) { YC[(size_t)(b * SEQ + 2048) * 1536 + d] = (bf16)f2bf(sacc * (1.f / 64.f) + U2048[it] + fourier_b[d]); YC[(size_t)(b * SEQ + 2048) * 1536 + 512 + d] = 0; } }
        REP(4) { const int di = F.vcu >> 1;
          pg8::Gemm g{DM, EO, 2048, (size_t)256 * 2048 * 2, (size_t)128 * 2048 * 2, (size_t)256 * 2048 * 2, (size_t)128 * 2048 * 2, 3, (size_t)2048 * 2048 * 2};
          pg8::OneUnit S{di >> 3, di & 7, (F.vcu & 1) == 0 && di < 128};
          pg8::EpiDFT E{YC, fourier_b, U2048};
          pg8::gemm_phase<pg8::EpiDFT, pg8::OneUnit>(F.lds + RING_OFF, g, S, E); }
        float lam;
        { const float a = lq1[F.lane] * lk1[F.lane], c = lq2[F.lane] * lk2[F.lane]; lam = expf(wave_sum(a)) - expf(wave_sum(c)) + 0.2f; }
        REP(3) for (int uix = F.vcu; uix < 512; uix += F.G) {
            const int grp = uix / 32, qblk = uix % 32; const int b = grp >> 2, h = grp & 3;
            att::attn_unit(b, h, qblk, (const att::bf16*)Qb, (const att::bf16*)Kb, (const att::bf16*)Vb, YC, rel_bias, subln_g, lam, (char*)lds);
        }
        if (IN(3) && IN(5)) GRID_BAR();
    }
    if (IN(5)) {
        pg8::Gemm g{YC, Wo_t, 1536, (size_t)256 * 1536 * 2, (size_t)128 * 1536 * 2, (size_t)256 * 1536 * 2, (size_t)128 * 1536 * 2, 0, 0};
        pg8::StaticOrder S; S.init(M / 256, D / 256, F.G, (int)blockIdx.x);
        pg8::EpiResF32 E{x, out};
        pg8::gemm_phase<pg8::EpiResF32, pg8::StaticOrder>(F.lds + RING_OFF, g, S, E);
        if (BOTH(5)) GRID_BAR();
    }
    if (IN(6)) {
        for (int m = gw; m < M; m += NGW) rms_row_to_bf16(F.lane, out + (size_t)m * D, norm_ffn_g, XN + (size_t)(m + 1) * D);
        if (BOTH(6)) GRID_BAR();
    }
    if (IN(7)) {
        pg8::Gemm g{XN, Wup_t, D, (size_t)254 * D * 2, (size_t)128 * D * 2, (size_t)128 * D * 2, (size_t)DFF * D * 2, 0, 0};
        pg8::StaticOrder S; S.init(65, 22, F.G, (int)blockIdx.x);
        pg8::EpiConvAct E{ACT, conv_w, conv_b, (LAS float*)(F.lds + XCH_OFF)};
        REP(7) pg8::gemm_phase<pg8::EpiConvAct, pg8::StaticOrder>(F.lds + RING_OFF, g, S, E);
        if (BOTH(7)) GRID_BAR();
    }
    if (IN(8)) {
        pg8::Gemm g{ACT, Wd_t, DFF, (size_t)256 * DFF * 2, (size_t)128 * DFF * 2, (size_t)256 * DFF * 2, (size_t)128 * DFF * 2, 0, 0};
        pg8::StaticOrder S; S.init(M / 256, D / 256, F.G, (int)blockIdx.x);
        pg8::EpiResF32 E{out, out};
        pg8::gemm_phase<pg8::EpiResF32, pg8::StaticOrder>(F.lds + RING_OFF, g, S, E);
        if (BOTH(8)) GRID_BAR();
    }
    if (IN(9)) {
        for (int m = gw; m < M; m += NGW) rms_row_f32(F.lane, out + (size_t)m * D, norm_final_g, out + (size_t)m * D);
    }
#undef IN
#undef BOTH
}

extern "C" void kernel_launch(void* const* d_in, const int* in_sizes, int n_in, void* d_out, int out_size, void* d_ws, size_t ws_size, hipStream_t stream) {
    static int grid = 0;
    if (grid == 0) {
        if (n_in != 18 || in_sizes[0] != M * D || out_size != M * D || ws_size < WS_END) { fprintf(stderr, "kernel_launch: unexpected shapes (n_in %d, in0 %d, out %d, ws %zu)\n", n_in, n_in > 0 ? in_sizes[0] : -1, out_size, ws_size); grid = -1; return; }
        int dev = 0, cus = 0, per_cu = 0;
        if (hipGetDevice(&dev) != hipSuccess || hipDeviceGetAttribute(&cus, hipDeviceAttributeMultiprocessorCount, dev) != hipSuccess) { grid = -1; return; }
        if (hipFuncSetAttribute((const void*)enc_fwd, hipFuncAttributeMaxDynamicSharedMemorySize, LDS_BYTES) != hipSuccess) { fprintf(stderr, "kernel_launch: hipFuncSetAttribute failed\n"); grid = -1; return; }
        if (hipOccupancyMaxActiveBlocksPerMultiprocessor(&per_cu, (const void*)enc_fwd, NWAVES * 64, LDS_BYTES) != hipSuccess || per_cu < 1) { fprintf(stderr, "kernel_launch: occupancy query says %d blocks per CU\n", per_cu); }
        (void)hipGetLastError();
        grid = cus;
    }
    if (grid < 0) return;
    (void)hipMemsetAsync((char*)d_ws + WS_CTL, 0, CTL_ZERO_BYTES, stream);
    Args a{};
    for (int i = 0; i < 18; ++i) a.in[i] = (const float*)d_in[i];
    a.out = (float*)d_out; a.ws = (unsigned char*)d_ws;
    if (MK_N_LAUNCHES == 1) {
        a.ph_lo = 0; a.ph_hi = N_PHASES; a.li = 0;
        hipLaunchKernelGGL(enc_fwd, dim3(grid), dim3(NWAVES * 64), LDS_BYTES, stream, a);
    } else {
        for (int li = 0; li < N_PHASES; ++li) { a.ph_lo = li; a.ph_hi = li + 1; a.li = li;
            hipLaunchKernelGGL(enc_fwd, dim3(grid), dim3(NWAVES * 64), LDS_BYTES, stream, a); }
    }
}
```

```cpp
#include <hip/hip_runtime.h>
#include <hip/hip_bf16.h>
#include <cstdio>
#include <cstdint>

#ifndef MK_N_LAUNCHES
#define MK_N_LAUNCHES 1
#endif
constexpr int N_PHASES = 10;

constexpr int D = 1024, BATCH = 4, SEQ = 4096, M = BATCH * SEQ, FW = 512, NH = 4, DFF = 2816, NUP = 2 * DFF;
constexpr float EPS = 1e-6f, LOG2E = 1.4426950408889634f;

namespace pg8 {
#define PG8_LAS __attribute__((address_space(3)))
typedef unsigned short bf16_t;
typedef short bf16x8 __attribute__((ext_vector_type(8)));
typedef float f32x4 __attribute__((ext_vector_type(4)));
typedef unsigned u32x4 __attribute__((ext_vector_type(4)));
typedef unsigned u32x2 __attribute__((ext_vector_type(2)));
constexpr int BM = 256, BK = 64, HALF = 128, HTB = HALF * BK * 2, STAGE_BYTES = 8 * HTB, NXCD = 8, WGM = 8;

__host__ __device__ __forceinline__ int lds_byte(int r, int c) { const int st = (r >> 4) * 2 + (c >> 5), rr = r & 15, cc = c & 31, ob = rr * 64 + cc * 2; return st * 1024 + (ob ^ (((ob >> 9) & 1) << 5)); }
__host__ __device__ __forceinline__ void stage_rc(int b, int& R, int& C) { const int st = b / 1024, sb = b % 1024, swz = sb ^ (((sb >> 9) & 1) << 5); R = (st >> 1) * 16 + swz / 64; C = (st & 1) * 32 + (swz % 64) / 2; }
__host__ __device__ __forceinline__ int perm32(int rho) { const int n = rho >> 4, i = rho & 15; return 8 * (i >> 2) + 4 * n + (i & 3); }

struct Unit { int pm, pn; };
struct Gemm { const bf16_t* A; const bf16_t* Bt; int K; size_t tstepA, hstepA, tstepB, hstepB; int pmsh; size_t bpm; };
struct OneUnit { int pm, pn; bool has; __device__ __forceinline__ bool next(int i, Unit& u) const { if (i > 0 || !has) return false; u.pm = pm; u.pn = pn; return true; } };

struct StaticOrder {
    int nM, nN, nwg, G, c;
    __host__ __device__ void init(int nM_, int nN_, int G_, int c_) { nM = nM_; nN = nN_; nwg = nM * nN; G = G_; c = c_; }
    __host__ __device__ bool next(int i, Unit& u) const {
        const long L = (long)i * G + c; if (L >= nwg) return false;
        int wgid = (int)L; { const int q = nwg / NXCD, r = nwg % NXCD, xcd = wgid % NXCD, off = wgid / NXCD; wgid = (xcd < r ? xcd * (q + 1) : r * (q + 1) + (xcd - r) * q) + off; }
        const int nig = WGM * nN, gid = wgid / nig, fm = gid * WGM, gsz = (nM - fm) < WGM ? (nM - fm) : WGM;
        u.pm = fm + ((wgid % nig) % gsz); u.pn = (wgid % nig) / gsz; return true;
    }
};

__device__ __forceinline__ unsigned cvt_pk_bf16(float lo, float hi) { unsigned r; asm volatile("v_cvt_pk_bf16_f32 %0, %1, %2" : "=v"(r) : "v"(lo), "v"(hi)); return r; }


struct EpiQKV {
    static constexpr bool PERM = true, NEEDS_SYNC = false;
    bf16_t* O; size_t split_stride; float scale0; float* knorm2;
    __device__ __forceinline__ void operator()(const f32x4 (&acc)[2][2][4][2], const Unit& u, int wr, int wc, int fr, int fq) const {
        const int row0 = u.pm * BM + wr * 64 + fr; int colt = u.pn * BM; bf16_t* base = O;
        const int t = colt / 512; base += (size_t)t * split_stride; colt -= t * 512; const float sc = (t == 0) ? scale0 : 1.f;
        const int col0 = colt + wc * 32 + 8 * fq;
#pragma unroll
        for (int ai = 0; ai < 2; ++ai)
#pragma unroll
            for (int m = 0; m < 4; ++m) { bf16_t* rowp = base + (size_t)(row0 + ai * HALF + m * 16) * 512 + col0;
#pragma unroll
                for (int bj = 0; bj < 2; ++bj) { f32x4 v0 = acc[ai][bj][m][0] * sc, v1 = acc[ai][bj][m][1] * sc;
                    u32x4 w; w.x = cvt_pk_bf16(v0[0], v0[1]); w.y = cvt_pk_bf16(v0[2], v0[3]); w.z = cvt_pk_bf16(v1[0], v1[1]); w.w = cvt_pk_bf16(v1[2], v1[3]);
                    *(u32x4*)(rowp + bj * HALF) = w; } }
        if (t == 1) {
#pragma unroll
            for (int ai = 0; ai < 2; ++ai)
#pragma unroll
                for (int m = 0; m < 4; ++m)
#pragma unroll
                    for (int bj = 0; bj < 2; ++bj) { const f32x4 a = acc[ai][bj][m][0], c = acc[ai][bj][m][1];
                        float q = (a[0] * a[0] + a[1] * a[1]) + (a[2] * a[2] + a[3] * a[3]) + (c[0] * c[0] + c[1] * c[1]) + (c[2] * c[2] + c[3] * c[3]);
                        q += __shfl_xor(q, 16); q += __shfl_xor(q, 32);
                        if (fq == 0) atomicAdd(knorm2 + (size_t)(row0 + ai * HALF + m * 16) * 8 + ((colt >> 7) + bj) * 2 + (wc >> 1), q); }
        }
    }
};
struct EpiEO {
    static constexpr bool PERM = true, NEEDS_SYNC = false;
    bf16_t* EO;
    __device__ __forceinline__ void operator()(const f32x4 (&acc)[2][2][4][2], const Unit& u, int wr, int wc, int fr, int fq) const {
        const int b = u.pn >> 3, s0 = (u.pn & 7) * 256 + wc * 32 + 8 * fq, part = u.pm >> 1;
#pragma unroll
        for (int ai = 0; ai < 2; ++ai)
#pragma unroll
            for (int m = 0; m < 4; ++m) { const int d = (u.pm & 1) * BM + ai * HALF + wr * 64 + m * 16 + fr;
                bf16_t* rowp = EO + ((size_t)part * 2048 * 2048 + (size_t)(b * 512 + d) * 2048 + s0);
#pragma unroll
                for (int bj = 0; bj < 2; ++bj) { const f32x4 v0 = acc[ai][bj][m][0], v1 = acc[ai][bj][m][1];
                    u32x4 w; w.x = cvt_pk_bf16(v0[0], v0[1]); w.y = cvt_pk_bf16(v0[2], v0[3]); w.z = cvt_pk_bf16(v1[0], v1[1]); w.w = cvt_pk_bf16(v1[2], v1[3]);
                    *(u32x4*)(rowp + bj * HALF) = w; } }
    }
};
struct EpiDFT {
    static constexpr bool PERM = true, NEEDS_SYNC = false;
    bf16_t* YC; const float* fb; const float* u2048;
    __device__ __forceinline__ void operator()(const f32x4 (&acc)[2][2][4][2], const Unit& u, int wr, int wc, int fr, int fq) const {
        const int type = u.pm >> 3, b = u.pn >> 1, d0 = (u.pn & 1) * 256 + wc * 32 + 8 * fq;
        f32x4 bv[2][2], uv[2][2];
#pragma unroll
        for (int bj = 0; bj < 2; ++bj)
#pragma unroll
            for (int n = 0; n < 2; ++n) { bv[bj][n] = type ? (f32x4){0.f, 0.f, 0.f, 0.f} : *(const f32x4*)(fb + d0 + bj * HALF + 4 * n);
                                          uv[bj][n] = type ? (f32x4){0.f, 0.f, 0.f, 0.f} : *(const f32x4*)(u2048 + b * 512 + d0 + bj * HALF + 4 * n); }
        const float sg = type ? -1.f : 1.f;
#pragma unroll
        for (int ai = 0; ai < 2; ++ai)
#pragma unroll
            for (int m = 0; m < 4; ++m) { const int sp = (u.pm & 7) * BM + ai * HALF + wr * 64 + m * 16 + fr; const float par = (sp & 1) ? -1.f : 1.f;
                bf16_t* row1 = YC + ((size_t)(b * 4096 + sp) * 1536 + type * 512 + d0);
                bf16_t* row2 = YC + ((size_t)(b * 4096 + ((4096 - sp) & 4095)) * 1536 + type * 512 + d0);
#pragma unroll
                for (int bj = 0; bj < 2; ++bj) { const f32x4 t0 = acc[ai][bj][m][0], t1 = acc[ai][bj][m][1];
                    const f32x4 c0 = uv[bj][0] * par + bv[bj][0], c1 = uv[bj][1] * par + bv[bj][1];
                    const f32x4 v0 = t0 * sg + c0, v1 = t1 * sg + c1;
                    u32x4 w; w.x = cvt_pk_bf16(v0[0], v0[1]); w.y = cvt_pk_bf16(v0[2], v0[3]); w.z = cvt_pk_bf16(v1[0], v1[1]); w.w = cvt_pk_bf16(v1[2], v1[3]);
                    *(u32x4*)(row1 + bj * HALF) = w;
                    if (sp != 0) { const f32x4 x0 = t0 + c0, x1 = t1 + c1;
                        u32x4 w2; w2.x = cvt_pk_bf16(x0[0], x0[1]); w2.y = cvt_pk_bf16(x0[2], x0[3]); w2.z = cvt_pk_bf16(x1[0], x1[1]); w2.w = cvt_pk_bf16(x1[2], x1[3]);
                        *(u32x4*)(row2 + bj * HALF) = w2; } } }
    }
};
struct EpiResF32 {
    static constexpr bool PERM = false, NEEDS_SYNC = false;
    const float* base; float* out;
    __device__ __forceinline__ void operator()(const f32x4 (&acc)[2][2][4][2], const Unit& u, int wr, int wc, int fr, int fq) const {
        const int row0 = u.pm * BM + wr * 64 + fr, col0 = u.pn * BM + wc * 32 + 4 * fq;
#pragma unroll
        for (int ai = 0; ai < 2; ++ai)
#pragma unroll
            for (int m = 0; m < 4; ++m) { const size_t off = (size_t)(row0 + ai * HALF + m * 16) * 1024 + col0;
#pragma unroll
                for (int bj = 0; bj < 2; ++bj)
#pragma unroll
                    for (int n = 0; n < 2; ++n) { const f32x4 bs = *(const f32x4*)(base + off + bj * HALF + n * 16); *(f32x4*)(out + off + bj * HALF + n * 16) = bs + acc[ai][bj][m][n]; } }
    }
};

__device__ __forceinline__ float dpp_shr1(float old, float src) { return __builtin_bit_cast(float, __builtin_amdgcn_update_dpp(__builtin_bit_cast(int, old), __builtin_bit_cast(int, src), 0x111, 0xf, 0xf, false)); }
__device__ __forceinline__ float dpp_shl1(float old, float src) { return __builtin_bit_cast(float, __builtin_amdgcn_update_dpp(__builtin_bit_cast(int, old), __builtin_bit_cast(int, src), 0x101, 0xf, 0xf, false)); }
__device__ __forceinline__ float dpp_ror1(float src) { return __builtin_bit_cast(float, __builtin_amdgcn_update_dpp(0, __builtin_bit_cast(int, src), 0x121, 0xf, 0xf, false)); }
__device__ __forceinline__ float dpp_rol1(float src) { return __builtin_bit_cast(float, __builtin_amdgcn_update_dpp(0, __builtin_bit_cast(int, src), 0x12F, 0xf, 0xf, false)); }

struct EpiConvAct {
    static constexpr bool PERM = true, NEEDS_SYNC = true;
    bf16_t* ACT; const float* conv_w; const float* conv_b; PG8_LAS float* xch;
    __device__ __forceinline__ void operator()(const f32x4 (&acc)[2][2][4][2], const Unit& u, int wr, int wc, int fr, int fq) const {
        const int tc0 = wc * 32 + 8 * fq;
#pragma unroll
        for (int ai = 0; ai < 2; ++ai) { const int ch = 2 * ai + wr;
#pragma unroll
            for (int bj = 0; bj < 2; ++bj)
#pragma unroll
                for (int n = 0; n < 2; ++n) {
                    if (fr == 0)  *(PG8_LAS f32x4*)(xch + (ch * 2 + 0) * 256 + bj * HALF + tc0 + 4 * n) = acc[ai][bj][0][n];
                    if (fr == 15) *(PG8_LAS f32x4*)(xch + (ch * 2 + 1) * 256 + bj * HALF + tc0 + 4 * n) = acc[ai][bj][3][n]; } }
        asm volatile("s_waitcnt lgkmcnt(0)" ::: "memory"); __builtin_amdgcn_s_barrier(); asm volatile("" ::: "memory");
        const int jg = u.pn * HALF + tc0;
#pragma unroll
        for (int n = 0; n < 2; ++n) {
            f32x4 w0[2], w1[2], w2[2], cb[2];
#pragma unroll
            for (int bj = 0; bj < 2; ++bj) { const int ch = bj * DFF + jg + 4 * n;
                w0[bj] = *(const f32x4*)(conv_w + ch); w1[bj] = *(const f32x4*)(conv_w + NUP + ch); w2[bj] = *(const f32x4*)(conv_w + 2 * NUP + ch); cb[bj] = *(const f32x4*)(conv_b + ch); }
#pragma unroll
            for (int ai = 0; ai < 2; ++ai) { const int ch = 2 * ai + wr;
                f32x4 xup[2], xdn[2];
#pragma unroll
                for (int bj = 0; bj < 2; ++bj) {
                    xup[bj] = *(const PG8_LAS f32x4*)(xch + (((ch + 3) & 3) * 2 + 1) * 256 + bj * HALF + tc0 + 4 * n);
                    xdn[bj] = *(const PG8_LAS f32x4*)(xch + (((ch + 1) & 3) * 2 + 0) * 256 + bj * HALF + tc0 + 4 * n); }
#pragma unroll
                for (int m = 0; m < 4; ++m) {
                    const int tr = ai * HALF + wr * 64 + m * 16 + fr; const int g = u.pm * 254 - 1 + tr;
                    const bool has_up = (g & 4095) != 0, has_dn = (g & 4095) != 4095;
                    float cv[2][4];
#pragma unroll
                    for (int bj = 0; bj < 2; ++bj)
#pragma unroll
                        for (int e = 0; e < 4; ++e) {
                            const float cur = acc[ai][bj][m][n][e];
                            float up, dn;
                            if (m == 0) up = dpp_shr1(xup[bj][e], cur); else up = dpp_shr1(dpp_ror1(acc[ai][bj][m - 1][n][e]), cur);
                            if (m == 3) dn = dpp_shl1(xdn[bj][e], cur); else dn = dpp_shl1(dpp_rol1(acc[ai][bj][m + 1][n][e]), cur);
                            up = has_up ? up : 0.f; dn = has_dn ? dn : 0.f;
                            cv[bj][e] = w0[bj][e] * up + (w1[bj][e] * cur + (w2[bj][e] * dn + cb[bj][e]));
                        }
                    float a[4];
#pragma unroll
                    for (int e = 0; e < 4; ++e) { const float gt = cv[0][e]; const float sg = __builtin_amdgcn_rcpf(1.f + __builtin_amdgcn_exp2f(-LOG2E * gt)); a[e] = gt * sg * cv[1][e]; }
                    u32x2 w; w.x = cvt_pk_bf16(a[0], a[1]); w.y = cvt_pk_bf16(a[2], a[3]);
                    if (tr >= 1 && tr <= 254 && g < M) *(u32x2*)(ACT + (size_t)g * DFF + jg + 4 * n) = w;
                }
            }
        }
        asm volatile("s_waitcnt lgkmcnt(0)" ::: "memory"); __builtin_amdgcn_s_barrier(); asm volatile("" ::: "memory");
    }
};

template <class Epi, class Sched>
__device__ __forceinline__ void gemm_phase(PG8_LAS unsigned char* lds, const Gemm g, const Sched& S, const Epi& E) {
    const int tid = threadIdx.x, wid = __builtin_amdgcn_readfirstlane(tid >> 6), lane = tid & 63, wr = wid >> 2, wc = wid & 3, fr = lane & 15, fq = lane >> 4;
    const int K = g.K, nt = K / BK;
    unsigned voffA[2], voffB[2];
#pragma unroll
    for (int i = 0; i < 2; ++i) { int R, C; stage_rc(tid * 16 + i * 8192, R, C); const int Rb = Epi::PERM ? ((R & ~31) + perm32(R & 31)) : R;
        voffA[i] = (unsigned)(R * K + C) * 2u; voffB[i] = (unsigned)(Rb * K + C) * 2u; }
    const size_t kstep = (size_t)(BK * 2);
    const size_t hsA = g.hstepA, hsB = g.hstepB;
    const unsigned ldsw = (unsigned)wid * 1024u;
    const int aoff = lds_byte(wr * 64 + fr, fq * 8), boff = lds_byte(wc * 32 + fr, fq * 8);
#define PG8_SA(b, h) (((b) * 2 + (h)) * HTB)
#define PG8_SB(b, h) ((4 + (b) * 2 + (h)) * HTB)
#define PG8_STAGE(bufoff, gbase, voff) do { _Pragma("unroll") for (int _i = 0; _i < 2; ++_i) \
        __builtin_amdgcn_global_load_lds((const unsigned*)((const char*)(gbase) + (voff)[_i]), (PG8_LAS unsigned*)(lds + (bufoff) + ldsw + _i * 8192), 16, 0, 0); } while (0)
#define PG8_LDA(dst, b, h) do { _Pragma("unroll") for (int m = 0; m < 4; ++m) _Pragma("unroll") for (int k = 0; k < 2; ++k) dst[m][k] = *(const PG8_LAS bf16x8*)(lds + PG8_SA(b, h) + aoff + m * 2048 + k * 1024); } while (0)
#define PG8_LDB(dst, b, h) do { _Pragma("unroll") for (int n = 0; n < 2; ++n) _Pragma("unroll") for (int k = 0; k < 2; ++k) dst[n][k] = *(const PG8_LAS bf16x8*)(lds + PG8_SB(b, h) + boff + n * 2048 + k * 1024); } while (0)
#define PG8_MMA(ai, bj, At, Bt) do { __builtin_amdgcn_s_setprio(1); _Pragma("unroll") for (int m = 0; m < 4; ++m) _Pragma("unroll") for (int n = 0; n < 2; ++n) _Pragma("unroll") for (int k = 0; k < 2; ++k) \
        acc[ai][bj][m][n] = __builtin_amdgcn_mfma_f32_16x16x32_bf16(Bt[n][k], At[m][k], acc[ai][bj][m][n], 0, 0, 0); __builtin_amdgcn_s_setprio(0); } while (0)
#define PG8_WAIT_V(n) asm volatile("s_waitcnt vmcnt(" #n ")" ::: "memory")
#define PG8_WAIT_L(n) asm volatile("s_waitcnt lgkmcnt(" #n ")" ::: "memory")
#define PG8_BAR __builtin_amdgcn_s_barrier()
#define PG8_SCHED __builtin_amdgcn_sched_barrier(0)
    Unit cur, nxt; int ui = 0;
    if (!S.next(0, cur)) return;
    f32x4 acc[2][2][4][2];
#pragma unroll
    for (int a = 0; a < 2; ++a)
#pragma unroll
        for (int b = 0; b < 2; ++b)
#pragma unroll
            for (int m = 0; m < 4; ++m)
#pragma unroll
                for (int n = 0; n < 2; ++n) acc[a][b][m][n] = (f32x4){0.f, 0.f, 0.f, 0.f};
    bf16x8 At[4][2], B0[2][2], B1[2][2];
    const char* cA = (const char*)g.A + (size_t)cur.pm * g.tstepA; const char* cB = (const char*)g.Bt + (size_t)cur.pn * g.tstepB + (size_t)(cur.pm >> g.pmsh) * g.bpm;
    PG8_STAGE(PG8_SB(0, 0), cB, voffB); PG8_STAGE(PG8_SB(0, 1), cB + hsB, voffB); PG8_STAGE(PG8_SA(0, 0), cA, voffA); PG8_STAGE(PG8_SA(0, 1), cA + hsA, voffA);
    if (wr == 1) PG8_BAR;
    PG8_WAIT_V(2); PG8_BAR;
    PG8_STAGE(PG8_SB(1, 0), cB + kstep, voffB); PG8_STAGE(PG8_SA(1, 0), cA + kstep, voffA); PG8_STAGE(PG8_SB(1, 1), cB + hsB + kstep, voffB);
    PG8_WAIT_V(6); PG8_BAR;
    for (;;) {
        const bool has_next = S.next(ui + 1, nxt);
        const char* nA = has_next ? (const char*)g.A + (size_t)nxt.pm * g.tstepA : cA; const char* nB = has_next ? (const char*)g.Bt + (size_t)nxt.pn * g.tstepB + (size_t)(nxt.pm >> g.pmsh) * g.bpm : cB;
        for (int t = 0; t < nt; t += 2) {
            const bool last = (t == nt - 2);
            const char* a1 = cA + (size_t)(t + 1) * kstep;
            const char* a2 = last ? nA : cA + (size_t)(t + 2) * kstep; const char* b2 = last ? nB : cB + (size_t)(t + 2) * kstep;
            const char* a3 = a2 + kstep; const char* b3 = b2 + kstep;
            PG8_LDB(B0, 0, 0); PG8_LDB(B1, 0, 1); PG8_SCHED; PG8_LDA(At, 0, 0); PG8_STAGE(PG8_SA(1, 1), a1 + hsA, voffA);
            PG8_WAIT_V(8); PG8_WAIT_L(0); PG8_BAR; PG8_MMA(0, 0, At, B0); PG8_MMA(0, 1, At, B1); PG8_BAR; PG8_SCHED;
            PG8_LDA(At, 0, 1); PG8_STAGE(PG8_SB(0, 0), b2, voffB); PG8_STAGE(PG8_SB(0, 1), b2 + hsB, voffB); PG8_STAGE(PG8_SA(0, 0), a2, voffA);
            PG8_WAIT_V(8); PG8_WAIT_L(0); PG8_BAR; PG8_MMA(1, 0, At, B0); PG8_MMA(1, 1, At, B1); PG8_BAR; PG8_SCHED;
            PG8_LDB(B0, 1, 0); PG8_LDB(B1, 1, 1); PG8_SCHED; PG8_LDA(At, 1, 0); PG8_STAGE(PG8_SA(0, 1), a2 + hsA, voffA);
            PG8_WAIT_V(8); PG8_WAIT_L(0); PG8_BAR; PG8_MMA(0, 0, At, B0); PG8_MMA(0, 1, At, B1); PG8_BAR; PG8_SCHED;
            PG8_LDA(At, 1, 1); PG8_STAGE(PG8_SB(1, 0), b3, voffB); PG8_STAGE(PG8_SB(1, 1), b3 + hsB, voffB); PG8_STAGE(PG8_SA(1, 0), a3, voffA);
            PG8_WAIT_V(8); PG8_WAIT_L(0); PG8_BAR; PG8_MMA(1, 0, At, B0); PG8_MMA(1, 1, At, B1); PG8_BAR; PG8_SCHED;
        }
        if (wr == 0) PG8_BAR;
        E(acc, cur, wr, wc, fr, fq);
        if (!has_next) break;
#pragma unroll
        for (int a = 0; a < 2; ++a)
#pragma unroll
            for (int b = 0; b < 2; ++b)
#pragma unroll
                for (int m = 0; m < 4; ++m)
#pragma unroll
                    for (int n = 0; n < 2; ++n) acc[a][b][m][n] = (f32x4){0.f, 0.f, 0.f, 0.f};
        cur = nxt; cA = nA; cB = nB; ++ui;
        if (wr == 1) PG8_BAR;
    }
    PG8_WAIT_V(0);
    PG8_BAR;
#undef PG8_SA
#undef PG8_SB
#undef PG8_STAGE
#undef PG8_LDA
#undef PG8_LDB
#undef PG8_MMA
#undef PG8_WAIT_V
#undef PG8_WAIT_L
#undef PG8_BAR
#undef PG8_SCHED
}
}

namespace att {
using bf16 = __hip_bfloat16;
using bf16x8 = __attribute__((ext_vector_type(8))) short;
using s16x4  = __attribute__((ext_vector_type(4))) short;
using f32x16 = __attribute__((ext_vector_type(16))) float;
using f32x4  = __attribute__((ext_vector_type(4))) float;
using u32x4  = __attribute__((ext_vector_type(4))) unsigned;
constexpr int NW = 8, QBLK = 32, KVBLK = 64, LDK = 512;
constexpr size_t SHM_V = KVBLK * 128 * 2, SHM_K = KVBLK * 128 * 2;
constexpr int OFF_V = 0, OFF_K = 2 * (int)SHM_V;
constexpr int OFF_K2 = 0, OFF_V3 = 2 * (int)SHM_K;
constexpr int OFF_WS = 6 * (int)SHM_K, OFF_TB = OFF_WS + NW * 64 * 4, OFF_X = 0  , XS = 132, X_FLOATS = 32 * XS;
constexpr int LDS_BYTES = OFF_TB + 2304;
static_assert(4 * X_FLOATS * 4 <= OFF_WS, "X overlay");
constexpr float THRL = 8.f * LOG2E;
#define KSWZ(row, colB) ((row) * 256 + ((colB) ^ (((row) & 7) << 4)))
#define SBAR() __builtin_amdgcn_sched_barrier(0)
__device__ __forceinline__ int crow(int r, int hi) { return (r & 3) + 8 * (r >> 2) + 4 * hi; }
__device__ __forceinline__ unsigned cvtpk(float lo, float hi) { unsigned r; asm volatile("v_cvt_pk_bf16_f32 %0, %1, %2" : "=v"(r) : "v"(lo), "v"(hi)); return r; }
__device__ __forceinline__ int t5_bucket(int rel) {
    const int n = rel < 0 ? -rel : rel; int v;
    if (n < 8) v = n; else if (n < 12) v = 8; else if (n < 16) v = 9; else if (n < 23) v = 10; else if (n < 32) v = 11; else if (n < 46) v = 12; else if (n < 64) v = 13; else if (n < 91) v = 14; else v = 15;
    return (rel > 0 ? 16 : 0) + v;
}
__device__ __forceinline__ void partialSM(f32x16& p0, f32x16& p1, float& m_reg, float& mn, float& alpha) {
  float pmax = p0[0];
#pragma unroll
  for (int r = 1; r < 16; ++r) pmax = fmaxf(pmax, p0[r]);
#pragma unroll
  for (int r = 0; r < 16; ++r) pmax = fmaxf(pmax, p1[r]);
  { auto rr = __builtin_amdgcn_permlane32_swap(__float_as_uint(pmax), __float_as_uint(pmax), false, false);
    pmax = fmaxf(__uint_as_float(rr[0]), __uint_as_float(rr[1])); }
  if (__builtin_expect(__all(pmax - m_reg <= THRL), 1)) { mn = m_reg; alpha = 1.f; }
  else { mn = fmaxf(m_reg, pmax); alpha = __builtin_amdgcn_exp2f(m_reg - mn); m_reg = mn; }
#pragma unroll
  for (int r = 0; r < 16; ++r) p0[r] = p0[r] - mn;
#pragma unroll
  for (int r = 0; r < 16; ++r) p1[r] = p1[r] - mn;
#pragma unroll
  for (int r = 0; r < 16; ++r) p0[r] = __builtin_amdgcn_exp2f(p0[r]);
}
__device__ __forceinline__ void finishSM(f32x16& p0, f32x16& p1, float alpha, float& l_reg, bf16x8& pa0, bf16x8& pa1, bf16x8& pa2, bf16x8& pa3) {
#pragma unroll
  for (int r = 0; r < 16; ++r) p1[r] = __builtin_amdgcn_exp2f(p1[r]);
  float ps = 0;
#pragma unroll
  for (int r = 0; r < 16; ++r) ps += p0[r];
#pragma unroll
  for (int r = 0; r < 16; ++r) ps += p1[r];
  { auto rr = __builtin_amdgcn_permlane32_swap(__float_as_uint(ps), __float_as_uint(ps), false, false);
    ps = __uint_as_float(rr[0]) + __uint_as_float(rr[1]); }
  l_reg = l_reg * alpha + ps;
#define PK4(P, BASE, OUT) do { unsigned a0 = cvtpk(P[BASE + 0], P[BASE + 1]), a1 = cvtpk(P[BASE + 2], P[BASE + 3]);   \
    unsigned b0 = cvtpk(P[BASE + 4], P[BASE + 5]), b1 = cvtpk(P[BASE + 6], P[BASE + 7]);                              \
    auto r0 = __builtin_amdgcn_permlane32_swap(a0, b0, false, false); auto r1 = __builtin_amdgcn_permlane32_swap(a1, b1, false, false); \
    u32x4 w = {r0[0], r1[0], r0[1], r1[1]}; OUT = *reinterpret_cast<bf16x8*>(&w); } while (0)
  PK4(p0, 0, pa0); PK4(p0, 8, pa1); PK4(p1, 0, pa2); PK4(p1, 8, pa3);
#undef PK4
}
__device__ __forceinline__ void qkt(f32x16& p0, f32x16& p1, const bf16* Ks, const bf16x8* qr, int r32, int hi, int mp) {
#pragma unroll
  for (int d0 = 0; d0 < 4; ++d0) { int cb = (mp * 64 + d0 * 16 + hi * 8) * 2;
    bf16x8 b0 = *reinterpret_cast<const bf16x8*>((const char*)Ks + KSWZ(r32, cb));
    bf16x8 b1 = *reinterpret_cast<const bf16x8*>((const char*)Ks + KSWZ(32 + r32, cb));
    p0 = __builtin_amdgcn_mfma_f32_32x32x16_bf16(b0, qr[d0], p0, 0, 0, 0);
    p1 = __builtin_amdgcn_mfma_f32_32x32x16_bf16(b1, qr[d0], p1, 0, 0, 0); }
}
__device__ __forceinline__ void binit(f32x16& p0, f32x16& p1, const float* tb, int j, int qw0  , int qpos, int hi) {
  const int relmin = 64 * j - (qw0 + 31), relmax = 64 * j + 63 - qw0;
  if (relmax <= -128) { const float c = tb[0];
#pragma unroll
    for (int r = 0; r < 16; ++r) { p0[r] = c; p1[r] = c; } }
  else if (relmin >= 128) { const float c = tb[512];
#pragma unroll
    for (int r = 0; r < 16; ++r) { p0[r] = c; p1[r] = c; } }
  else { const float* t = tb + (64 * j - qpos + 256 + 4 * hi);
#pragma unroll
    for (int r = 0; r < 16; ++r) { p0[r] = t[(r & 3) + 8 * (r >> 2)]; p1[r] = t[32 + (r & 3) + 8 * (r >> 2)]; } }
}
__device__ __forceinline__ int v_st(int k, int c) { const int kk = (k & ~0xC) | ((k & 4) << 1) | ((k & 8) >> 1); return ((kk >> 3) * 4 + (c >> 5)) * 512 + ((kk & 7) * 32 + (c & 31)) * 2; }
__device__ __forceinline__ int v_rd_base(int lane) { return ((lane & 3) << 3) | (((lane >> 2) & 3) << 6) | (((lane >> 4) & 1) << 5) | (((lane >> 5) & 1) << 8); }
constexpr int v_rd_off(int d0, int ks, int half) { return d0 * 512 + ks * 4096 + half * 2048; }
template <int OFF> __device__ __forceinline__ s16x4 tr_read(int vb) {
  s16x4 r; asm volatile("ds_read_b64_tr_b16 %0, %1 offset:%2" : "=&v"(r) : "v"(vb), "i"(OFF) : "memory"); return r;
}
template <int D0> __device__ __forceinline__ void pv_one(f32x16& od, int vb, bf16x8 pa0, bf16x8 pa1, bf16x8 pa2, bf16x8 pa3) {
  const s16x4 l0 = tr_read<v_rd_off(D0, 0, 0)>(vb), h0 = tr_read<v_rd_off(D0, 0, 1)>(vb), l1 = tr_read<v_rd_off(D0, 1, 0)>(vb), h1 = tr_read<v_rd_off(D0, 1, 1)>(vb);
  const s16x4 l2 = tr_read<v_rd_off(D0, 2, 0)>(vb), h2 = tr_read<v_rd_off(D0, 2, 1)>(vb), l3 = tr_read<v_rd_off(D0, 3, 0)>(vb), h3 = tr_read<v_rd_off(D0, 3, 1)>(vb);
  asm volatile("s_waitcnt lgkmcnt(0)" ::: "memory"); SBAR();
#define PK(L, H) (bf16x8){L[0], L[1], L[2], L[3], H[0], H[1], H[2], H[3]}
  od = __builtin_amdgcn_mfma_f32_32x32x16_bf16(pa0, PK(l0, h0), od, 0, 0, 0);
  od = __builtin_amdgcn_mfma_f32_32x32x16_bf16(pa1, PK(l1, h1), od, 0, 0, 0);
  od = __builtin_amdgcn_mfma_f32_32x32x16_bf16(pa2, PK(l2, h2), od, 0, 0, 0);
  od = __builtin_amdgcn_mfma_f32_32x32x16_bf16(pa3, PK(l3, h3), od, 0, 0, 0);
#undef PK
}
__device__ __forceinline__ void pv_d0(f32x16* o, int vb, bf16x8 pa0, bf16x8 pa1, bf16x8 pa2, bf16x8 pa3) {
  pv_one<0>(o[0], vb, pa0, pa1, pa2, pa3); pv_one<1>(o[1], vb, pa0, pa1, pa2, pa3); pv_one<2>(o[2], vb, pa0, pa1, pa2, pa3); pv_one<3>(o[3], vb, pa0, pa1, pa2, pa3);
}

__device__ __forceinline__ void attn_unit(int b, int h, int qblk, const bf16* __restrict__ Q, const bf16* __restrict__ K, const bf16* __restrict__ V,
                                          unsigned short* __restrict__ YC, const float* __restrict__ rel_bias, const float* __restrict__ subln_g, float lam, char* lds) {
  const int tid = threadIdx.x, wid = __builtin_amdgcn_readfirstlane(tid >> 6), lane = tid & 63, r32 = lane & 31, hi = lane >> 5;
  const int qg = wid & 3, mp = wid >> 2;
  bf16* V_lds = (bf16*)(lds + OFF_V); bf16* K_lds = (bf16*)(lds + OFF_K);
  float* ws = (float*)(lds + OFF_WS) + wid * 64; float* li_l = ws; float* al_l = ws + 32;
  float* tb = (float*)(lds + OFF_TB);
  for (int i = tid; i < 513; i += 512) tb[i] = rel_bias[t5_bucket(i - 256) * 4 + h] * LOG2E;
  const long tok0 = (long)b * SEQ; const int q0 = qblk * 128, qw0 = q0 + qg * 32, qpos = qw0 + r32;
  float m_reg = -1e30f, l_reg = 0; f32x16 o[4] = {}; bf16x8 qr[4];
  const bf16* Qw = Q + (tok0 + qpos) * LDK + h * 128 + mp * 64 + hi * 8;
#pragma unroll
  for (int d0 = 0; d0 < 4; ++d0) qr[d0] = *reinterpret_cast<const bf16x8*>(Qw + d0 * 16);
  const bf16* Kh = K + tok0 * LDK + h * 128; const bf16* Vh = V + tok0 * LDK + h * 128;
  const int sr = tid >> 4, sc = (tid & 15) * 8, vst0 = v_st(sr, sc), vst1 = v_st(32 + sr, sc);
  const int vb0 = (int)(uintptr_t)V_lds + v_rd_base(lane); const unsigned voff = (unsigned)((sr * LDK + sc) * 2);
  constexpr int NT = SEQ / KVBLK;
  for (int j = 0; j < NT; ++j) {
    { const char* kb_ = (const char*)Kh + (size_t)(j * KVBLK) * (LDK * 2); const char* vb_ = (const char*)Vh + (size_t)(j * KVBLK) * (LDK * 2);
      const bf16x8 vs0 = *reinterpret_cast<const bf16x8*>(vb_ + voff), vs1 = *reinterpret_cast<const bf16x8*>(vb_ + 32 * LDK * 2 + voff);
      const bf16x8 ks0 = *reinterpret_cast<const bf16x8*>(kb_ + voff), ks1 = *reinterpret_cast<const bf16x8*>(kb_ + 32 * LDK * 2 + voff);
      __syncthreads();
      *(bf16x8*)((char*)V_lds + vst0) = vs0; *(bf16x8*)((char*)V_lds + vst1) = vs1; const int kc = sc * 2;
      *(bf16x8*)((char*)K_lds + KSWZ(sr, kc)) = ks0; *(bf16x8*)((char*)K_lds + KSWZ(32 + sr, kc)) = ks1;
      __syncthreads(); }
    f32x16 p0, p1; float mn, alpha; bf16x8 pa0, pa1, pa2, pa3;
    binit(p0, p1, tb, j, qw0, qpos, hi);
    qkt(p0, p1, K_lds, qr, r32, hi, mp);
    partialSM(p0, p1, m_reg, mn, alpha);
    finishSM(p0, p1, alpha, l_reg, pa0, pa1, pa2, pa3);
    if (__any(alpha < 1.f)) { if (hi == 0) al_l[r32] = alpha; asm volatile("s_waitcnt lgkmcnt(0)" ::: "memory");
#pragma unroll
      for (int d = 0; d < 4; ++d)
#pragma unroll
        for (int r = 0; r < 16; ++r) o[d][r] *= al_l[crow(r, hi)]; }
    pv_d0(o, vb0, pa0, pa1, pa2, pa3);
  }
  __syncthreads();
  if (hi == 0) li_l[r32] = l_reg; asm volatile("s_waitcnt lgkmcnt(0)" ::: "memory");
  float rli[16]; const float scm = (mp == 0) ? 1.f : lam;
#pragma unroll
  for (int r = 0; r < 16; ++r) rli[r] = scm * __builtin_amdgcn_rcpf(li_l[crow(r, hi)]);
  float* X = (float*)(lds + OFF_X) + qg * X_FLOATS;
  if (mp == 1) {
#pragma unroll
    for (int r = 0; r < 16; ++r)
#pragma unroll
      for (int d0 = 0; d0 < 4; ++d0) X[crow(r, hi) * XS + d0 * 32 + r32] = o[d0][r] * rli[r];
  }
  __syncthreads();
  if (mp == 0) {
#pragma unroll
    for (int r = 0; r < 16; ++r)
#pragma unroll
      for (int d0 = 0; d0 < 4; ++d0) { float* p = &X[crow(r, hi) * XS + d0 * 32 + r32]; *p = o[d0][r] * rli[r] - *p; }
    asm volatile("s_waitcnt lgkmcnt(0)" ::: "memory");
    const int row = lane >> 1, hf = lane & 1;
    f32x4 v[16]; float ss = 0.f;
#pragma unroll
    for (int i = 0; i < 16; ++i) { v[i] = *(const f32x4*)&X[row * XS + hf * 64 + i * 4]; ss += (v[i][0] * v[i][0] + v[i][1] * v[i][1]) + (v[i][2] * v[i][2] + v[i][3] * v[i][3]); }
    ss += __shfl_xor(ss, 1);
    const float rs = 0.8f / sqrtf(ss * (1.f / 128.f) + EPS);
    unsigned short* dst = YC + (size_t)(tok0 + qw0 + row) * 1536 + 1024 + h * 128 + hf * 64;
#pragma unroll
    for (int i = 0; i < 8; ++i) { const f32x4 g0 = *(const f32x4*)(subln_g + hf * 64 + i * 8), g1 = *(const f32x4*)(subln_g + hf * 64 + i * 8 + 4);
      const f32x4 a = v[2 * i] * g0 * rs, c = v[2 * i + 1] * g1 * rs;
      u32x4 w = {cvtpk(a[0], a[1]), cvtpk(a[2], a[3]), cvtpk(c[0], c[1]), cvtpk(c[2], c[3])}; *(u32x4*)(dst + i * 8) = w; }
  }
  __syncthreads();
}
typedef __attribute__((address_space(3))) unsigned char lds_u8;
constexpr int NSLOT = 3, SLOTB = 16384;
constexpr int L3_K = 0, L3_V = NSLOT * SLOTB, L3_END = 2 * NSLOT * SLOTB;
static_assert(L3_END <= OFF_WS, "rings below the per-wave scratch");
typedef __attribute__((address_space(3))) const char* lds_cptr;
typedef short v4i16_t __attribute__((ext_vector_type(4)));
__device__ __forceinline__ void glds16(const void* gsrc, unsigned lds_dst) { unsigned keep;
  asm volatile("s_mov_b32 %0, m0\n\ts_mov_b32 m0, %2\n\ts_nop 0\n\tglobal_load_lds_dwordx4 %1, off\n\ts_mov_b32 m0, %0" : "=&s"(keep) : "v"(gsrc), "s"(lds_dst) : "memory"); }
__device__ __forceinline__ unsigned cvtpk_s(float lo, float hi) { typedef float f32x2_t __attribute__((ext_vector_type(2))); typedef __bf16 bf16x2_t __attribute__((ext_vector_type(2)));
  f32x2_t v = {lo, hi}; bf16x2_t b = __builtin_convertvector(v, bf16x2_t); return __builtin_bit_cast(unsigned, b); }
__device__ __forceinline__ s16x4 vtr(lds_cptr p) { return __builtin_bit_cast(s16x4, __builtin_amdgcn_ds_read_tr16_b64_v4i16((__attribute__((address_space(3))) v4i16_t*)p)); }
#define WAIT_BAR(N) asm volatile("s_waitcnt vmcnt(" #N ") lgkmcnt(0)\n\ts_barrier" ::: "memory")

__device__ __forceinline__ bool attn_unit_v3(int b, int h, int qblk, const bf16* __restrict__ Q, const bf16* __restrict__ K, const bf16* __restrict__ V,
                                             unsigned short* __restrict__ YC, const float* __restrict__ rel_bias, const float* __restrict__ subln_g, const float* __restrict__ knorm2, float lam, lds_u8* lds) {
  const int tid = threadIdx.x, wid = __builtin_amdgcn_readfirstlane(tid >> 6), lane = tid & 63, r32 = lane & 31, hi = lane >> 5;
  const int qg = wid & 3, mp = wid >> 2;
  typedef __attribute__((address_space(3))) float lds_f32;
  lds_f32* wsf = (lds_f32*)(lds + OFF_WS) + wid * 64;
  lds_f32* tb = (lds_f32*)(lds + OFF_TB);
  const long tok0 = (long)b * SEQ; const int q0 = qblk * 128, qw0 = q0 + qg * 32, qpos = qw0 + r32;
  float bmax = 0.f;
#pragma unroll 8
  for (int i = 0; i < 32; ++i) bmax = fmaxf(bmax, fabsf(rel_bias[i * 4 + h]));
  bmax *= LOG2E;
  for (int i = tid; i < 513; i += 512) tb[i] = rel_bias[t5_bucket(i - 256) * 4 + h] * LOG2E;
  { float k0 = 0.f, k1 = 0.f;
#pragma unroll
    for (int i = 0; i < 8; ++i) { const float* kn = knorm2 + (size_t)(tok0 + tid + i * 512) * 8 + h * 2; k0 = fmaxf(k0, kn[0]); k1 = fmaxf(k1, kn[1]); }
#pragma unroll
    for (int o = 1; o < 64; o <<= 1) { k0 = fmaxf(k0, __shfl_xor(k0, o)); k1 = fmaxf(k1, __shfl_xor(k1, o)); }
    if (lane == 0) { wsf[0] = k0; wsf[1] = k1; } }
  bf16x8 qr[4];
  const bf16* Qw = Q + (tok0 + qpos) * LDK + h * 128 + mp * 64 + hi * 8;
#pragma unroll
  for (int d0 = 0; d0 < 4; ++d0) qr[d0] = *reinterpret_cast<const bf16x8*>(Qw + d0 * 16);
  float qn2 = 0.f;
#pragma unroll
  for (int d0 = 0; d0 < 4; ++d0)
#pragma unroll
    for (int e = 0; e < 8; ++e) { const float f = __uint_as_float(((unsigned)(unsigned short)qr[d0][e]) << 16); qn2 += f * f; }
  { auto rr = __builtin_amdgcn_permlane32_swap(__float_as_uint(qn2), __float_as_uint(qn2), false, false); qn2 = __uint_as_float(rr[0]) + __uint_as_float(rr[1]); }
  asm volatile("s_waitcnt vmcnt(0) lgkmcnt(0)\n\ts_barrier" ::: "memory");
  float kmax2 = 0.f;
#pragma unroll
  for (int w = 0; w < 8; ++w) kmax2 = fmaxf(kmax2, ((lds_f32*)(lds + OFF_WS))[w * 64 + mp]);
  const float qk = sqrtf(qn2 * kmax2) * 1.01f;
  if (__syncthreads_or(qk + bmax > 60.f)) return false;
  const bf16* Kh = K + tok0 * LDK + h * 128; const bf16* Vh = V + tok0 * LDK + h * 128;
  const unsigned lds0 = (unsigned)(uintptr_t)lds;
  const bf16* ksrc = Kh + (long)lane * LDK + wid * 8;
  const bf16* vsrc = Vh + (long)(16 * (wid & 3) + (lane >> 2)) * LDK + (wid >> 2) * 32 + (lane & 3) * 8;
  const unsigned kdst = lds0 + L3_K + wid * 1024, vdst = lds0 + L3_V + wid * 1024;
#define DMA_K(t, slot) do { glds16(ksrc + (long)(t) * KVBLK * LDK, (unsigned)__builtin_amdgcn_readfirstlane(kdst + (slot))); \
                            glds16(ksrc + (long)(t) * KVBLK * LDK + 64, (unsigned)__builtin_amdgcn_readfirstlane(kdst + (slot) + 8192)); } while (0)
#define DMA_V(t, slot) do { glds16(vsrc + (long)(t) * KVBLK * LDK, (unsigned)__builtin_amdgcn_readfirstlane(vdst + (slot))); \
                            glds16(vsrc + (long)(t) * KVBLK * LDK + 64, (unsigned)__builtin_amdgcn_readfirstlane(vdst + (slot) + 8192)); } while (0)
  const lds_cptr shm3 = (lds_cptr)lds;
  const lds_cptr kp0 = shm3 + L3_K + mp * 8192 + hi * 1024 + r32 * 16;
  const lds_cptr vp0 = shm3 + L3_V + ((lane >> 4) & 1) * 32 + (lane & 3) * 8 + (4 * hi + ((lane & 15) >> 2)) * 64;
  constexpr int NT = SEQ / KVBLK;
  DMA_K(0, 0); DMA_V(0, 0); DMA_K(1, SLOTB); DMA_K(2, 2 * SLOTB);
  const float cL = tb[0], cR = tb[512];
#define KIND(j) ((64 * (j) + 63 - qw0 <= -128) ? 0 : ((64 * (j) - (qw0 + 31) >= 128) ? 2 : 1))
  int state = KIND(0);
  float l_reg = 0.f; f32x16 o[4]; o[0] = f32x16{}; o[1] = f32x16{}; o[2] = f32x16{}; o[3] = f32x16{};
  f32x16 pA0, pA1, pB0, pB1; bf16x8 kfA[8], kfB[8];
  const f32x16 Z = {};
#define KLOAD8(KF, kp) do { _Pragma("unroll") for (int d_ = 0; d_ < 4; ++d_) { KF[2 * d_] = *(const __attribute__((address_space(3))) bf16x8*)((kp) + d_ * 2048); KF[2 * d_ + 1] = *(const __attribute__((address_space(3))) bf16x8*)((kp) + d_ * 2048 + 512); } } while (0)
#define NEARFIX(P0, P1, j) do { if (KIND(j) == 1) { int ln_ = lane; asm volatile("" : "+v"(ln_)); const lds_f32* t_ = tb + (64 * (j) - (qw0 + (ln_ & 31)) + 256 + 4 * (ln_ >> 5)); \
      _Pragma("unroll") for (int r = 0; r < 16; ++r) { P0[r] += t_[(r & 3) + 8 * (r >> 2)]; P1[r] += t_[32 + (r & 3) + 8 * (r >> 2)]; } } } while (0)
#define RESCALE(PY0, PY1, j) do { const int kind_ = KIND(j); if (kind_ != state) { \
    const float f2_ = (state == 0 ? cL : 0.f) - (kind_ == 2 ? cR : 0.f); const float f_ = __builtin_amdgcn_exp2f(f2_); state = kind_; l_reg *= f_; \
    _Pragma("unroll") for (int d = 0; d < 4; ++d) _Pragma("unroll") for (int r = 0; r < 16; ++r) o[d][r] *= f_; \
    _Pragma("unroll") for (int r = 0; r < 16; ++r) { PY0[r] *= f_; PY1[r] *= f_; } } } while (0)
  int sl_prev = 0, sl_cur = 0, sl_next = SLOTB;
#define ROT() do { sl_prev = sl_cur; sl_cur = sl_next; sl_next = (sl_next == (NSLOT - 1) * SLOTB) ? 0 : sl_next + SLOTB; } while (0)
  WAIT_BAR(6);
  KLOAD8(kfA, kp0);
#pragma unroll
  for (int d0 = 0; d0 < 4; ++d0) {
    if (d0 == 0) { pA0 = __builtin_amdgcn_mfma_f32_32x32x16_bf16(kfA[0], qr[0], Z, 0, 0, 0); pA1 = __builtin_amdgcn_mfma_f32_32x32x16_bf16(kfA[1], qr[0], Z, 0, 0, 0); }
    else { pA0 = __builtin_amdgcn_mfma_f32_32x32x16_bf16(kfA[2 * d0], qr[d0], pA0, 0, 0, 0); pA1 = __builtin_amdgcn_mfma_f32_32x32x16_bf16(kfA[2 * d0 + 1], qr[d0], pA1, 0, 0, 0); } }
  NEARFIX(pA0, pA1, 0);
#pragma unroll
  for (int r = 0; r < 16; ++r) { pA0[r] = __builtin_amdgcn_exp2f(pA0[r]); pA1[r] = __builtin_amdgcn_exp2f(pA1[r]); }
  WAIT_BAR(0);
  DMA_K(3, 0); DMA_V(1, SLOTB);
  ROT();
  KLOAD8(kfB, kp0 + sl_cur);
  WAIT_BAR(4);
  s16x4 vlo[8], vhi[8], wlo[8], whi[8]; u32x4 pw0, pw1, pw2, pw3;
#define PKW(P, B) cvtpk_s(P[B], P[B + 1])
#define PAF(k) __builtin_bit_cast(bf16x8, pw##k)
#define VFR(i) (bf16x8){vlo[i][0], vlo[i][1], vlo[i][2], vlo[i][3], vhi[i][0], vhi[i][1], vhi[i][2], vhi[i][3]}
#define WFR(i) (bf16x8){wlo[i][0], wlo[i][1], wlo[i][2], wlo[i][3], whi[i][0], whi[i][1], whi[i][2], whi[i][3]}
#define PIN(x) asm volatile("" : "+v"(x))
#define MF(acc, a, b) acc = __builtin_amdgcn_mfma_f32_32x32x16_bf16(a, b, acc, 0, 0, 0)
#define EX(v) __builtin_amdgcn_exp2f(v)
#define GAPA(MFS, A0, A1, A2, A3, W0, W1, PW) do { MFS; sacc += A0; sacc += A1; sacc += A2; sacc += A3; PIN(sacc); W0; W1; PIN(PW); SBAR(); } while (0)
#define GAPB(MFS, X, B) do { MFS; X[B] = EX(X[B]); X[B + 1] = EX(X[B + 1]); PIN(X); SBAR(); } while (0)
#define VRD(i) do { vlo[i] = vtr(vp_ + (((i) >> 2) * 4096 + ((i) & 3) * 1024)); vhi[i] = vtr(vp_ + (((i) >> 2) * 4096 + ((i) & 3) * 1024 + 512)); } while (0)
#define WRD(i) do { wlo[i] = vtr(vp_ + ((2 + ((i) >> 2)) * 4096 + ((i) & 3) * 1024)); whi[i] = vtr(vp_ + ((2 + ((i) >> 2)) * 4096 + ((i) & 3) * 1024 + 512)); } while (0)
#define KRD(G, KN, j) do { if (G) { KN[2 * (j)] = *(const __attribute__((address_space(3))) bf16x8*)(kp0 + sl_next + (j) * 2048); KN[2 * (j) + 1] = *(const __attribute__((address_space(3))) bf16x8*)(kp0 + sl_next + (j) * 2048 + 512); } } while (0)
#define STEP(C0, C1, P0, P1, KC, KN, t, GK, GV, GL) do { RESCALE(P0, P1, t); SBAR(); \
    const lds_cptr vp_ = vp0 + sl_prev; \
    VRD(0); SBAR(); float sacc = (P0[0] + P0[1]); \
    GAPA(C0 = __builtin_amdgcn_mfma_f32_32x32x16_bf16(KC[0], qr[0], Z, 0, 0, 0), P0[2], P0[3], P0[4], P0[5],     pw0[0] = PKW(P0, 0), pw0[1] = PKW(P0, 2), pw0); \
    VRD(4); SBAR(); GAPA(C1 = __builtin_amdgcn_mfma_f32_32x32x16_bf16(KC[1], qr[0], Z, 0, 0, 0), P0[6], P0[7], P0[8], P0[9],     pw0[2] = PKW(P0, 4), pw0[3] = PKW(P0, 6), pw0); \
    VRD(1); SBAR(); GAPA(MF(C0, KC[2], qr[1]), P0[10], P0[11], P0[12], P0[13], pw1[0] = PKW(P0, 8), pw1[1] = PKW(P0, 10), pw1); \
    VRD(5); SBAR(); GAPA(MF(C1, KC[3], qr[1]), P0[14], P0[15], P1[0], P1[1],   pw1[2] = PKW(P0, 12), pw1[3] = PKW(P0, 14), pw1); \
    VRD(2); SBAR(); GAPA(MF(C0, KC[4], qr[2]), P1[2], P1[3], P1[4], P1[5],     pw2[0] = PKW(P1, 0), pw2[1] = PKW(P1, 2), pw2); \
    VRD(6); SBAR(); GAPA(MF(C1, KC[5], qr[2]), P1[6], P1[7], P1[8], P1[9],     pw2[2] = PKW(P1, 4), pw2[3] = PKW(P1, 6), pw2); \
    VRD(3); SBAR(); GAPA(MF(C0, KC[6], qr[3]), P1[10], P1[11], P1[12], P1[13], pw3[0] = PKW(P1, 8), pw3[1] = PKW(P1, 10), pw3); \
    VRD(7); SBAR(); GAPA(MF(C1, KC[7], qr[3]), P1[14], P1[15], 0.f, 0.f,       pw3[2] = PKW(P1, 12), pw3[3] = PKW(P1, 14), pw3); \
    l_reg += sacc; \
    if (GK) { DMA_K((t) + 3, sl_cur); } if (GV) { DMA_V((t) + 1, sl_next); } \
    NEARFIX(C0, C1, t); \
    SBAR(); \
    WRD(0); SBAR(); GAPB(MF(o[0], PAF(0), VFR(0)), C0, 0); \
    WRD(4); SBAR(); GAPB(MF(o[1], PAF(0), VFR(4)), C0, 2); \
    WRD(1); SBAR(); GAPB(MF(o[0], PAF(1), VFR(1)), C0, 4); \
    WRD(5); SBAR(); GAPB(MF(o[1], PAF(1), VFR(5)), C0, 6); \
    WRD(2); SBAR(); GAPB(MF(o[0], PAF(2), VFR(2)), C0, 8); \
    WRD(6); SBAR(); GAPB(MF(o[1], PAF(2), VFR(6)), C0, 10); \
    WRD(3); SBAR(); GAPB(MF(o[0], PAF(3), VFR(3)), C0, 12); \
    WRD(7); SBAR(); GAPB(MF(o[1], PAF(3), VFR(7)), C0, 14); \
    KRD(GL, KN, 0); SBAR(); GAPB(MF(o[2], PAF(0), WFR(0)), C1, 0); \
    GAPB(MF(o[3], PAF(0), WFR(4)), C1, 2); \
    KRD(GL, KN, 1); SBAR(); GAPB(MF(o[2], PAF(1), WFR(1)), C1, 4); \
    GAPB(MF(o[3], PAF(1), WFR(5)), C1, 6); \
    KRD(GL, KN, 2); SBAR(); GAPB(MF(o[2], PAF(2), WFR(2)), C1, 8); \
    GAPB(MF(o[3], PAF(2), WFR(6)), C1, 10); \
    KRD(GL, KN, 3); SBAR(); GAPB(MF(o[2], PAF(3), WFR(3)), C1, 12); \
    GAPB(MF(o[3], PAF(3), WFR(7)), C1, 14); \
    } while (0)
#define ENDW(tt) do { if ((tt) + 3 < NT) { WAIT_BAR(4); } else if ((tt) + 2 < NT) { WAIT_BAR(2); } else { WAIT_BAR(0); } } while (0)
  int t = 1;
  for (; t + 5 < NT; t += 2) {
    STEP(pB0, pB1, pA0, pA1, kfB, kfA, t, true, true, true);     WAIT_BAR(4); ROT();
    STEP(pA0, pA1, pB0, pB1, kfA, kfB, t + 1, true, true, true); WAIT_BAR(4); ROT();
  }
  for (; t + 1 < NT; t += 2) {
    STEP(pB0, pB1, pA0, pA1, kfB, kfA, t, (t + 3 < NT), (t + 1 < NT), (t + 1 < NT));         ENDW(t);     ROT();
    STEP(pA0, pA1, pB0, pB1, kfA, kfB, t + 1, (t + 4 < NT), (t + 2 < NT), (t + 2 < NT));     ENDW(t + 1); ROT();
  }
  STEP(pB0, pB1, pA0, pA1, kfB, kfA, NT - 1, false, false, false);
  { float sacc = 0.f;
#pragma unroll
    for (int r = 0; r < 16; ++r) sacc += pB0[r];
#pragma unroll
    for (int r = 0; r < 16; ++r) sacc += pB1[r];
    l_reg += sacc;
    pw0 = (u32x4){PKW(pB0, 0), PKW(pB0, 2), PKW(pB0, 4), PKW(pB0, 6)}; pw1 = (u32x4){PKW(pB0, 8), PKW(pB0, 10), PKW(pB0, 12), PKW(pB0, 14)};
    pw2 = (u32x4){PKW(pB1, 0), PKW(pB1, 2), PKW(pB1, 4), PKW(pB1, 6)}; pw3 = (u32x4){PKW(pB1, 8), PKW(pB1, 10), PKW(pB1, 12), PKW(pB1, 14)};
    SBAR();
    const lds_cptr vp_ = vp0 + sl_cur;
#pragma unroll
    for (int cb = 0; cb < 4; ++cb) { s16x4 lo[4], hh[4];
#pragma unroll
      for (int ks = 0; ks < 4; ++ks) { lo[ks] = vtr(vp_ + cb * 4096 + ks * 1024); hh[ks] = vtr(vp_ + cb * 4096 + ks * 1024 + 512); }
#define PKV(k) (bf16x8){lo[k][0], lo[k][1], lo[k][2], lo[k][3], hh[k][0], hh[k][1], hh[k][2], hh[k][3]}
      MF(o[cb], PAF(0), PKV(0)); MF(o[cb], PAF(1), PKV(1)); MF(o[cb], PAF(2), PKV(2)); MF(o[cb], PAF(3), PKV(3));
#undef PKV
    } }
  asm volatile("s_waitcnt vmcnt(0) lgkmcnt(0)\n\ts_barrier" ::: "memory");
  int lane_e = lane; asm volatile("" : "+v"(lane_e));
  const int r32e = lane_e & 31, hie = lane_e >> 5;
  float ls = l_reg;
  { auto rr = __builtin_amdgcn_permlane32_swap(__float_as_uint(ls), __float_as_uint(ls), false, false); ls = __uint_as_float(rr[0]) + __uint_as_float(rr[1]); }
  if (hie == 0) wsf[r32e] = ls; asm volatile("s_waitcnt lgkmcnt(0)" ::: "memory");
  float rli[16]; const float scm = (mp == 0) ? 1.f : lam;
#pragma unroll
  for (int r = 0; r < 16; ++r) rli[r] = scm * __builtin_amdgcn_rcpf(wsf[crow(r, hie)]);
  lds_f32* X = (lds_f32*)(lds + OFF_X) + qg * X_FLOATS;
  if (mp == 1) {
#pragma unroll
    for (int r = 0; r < 16; ++r)
#pragma unroll
      for (int d0 = 0; d0 < 4; ++d0) X[crow(r, hie) * XS + d0 * 32 + r32e] = o[d0][r] * rli[r];
  }
  asm volatile("s_waitcnt lgkmcnt(0)\n\ts_barrier" ::: "memory");
  if (mp == 0) {
#pragma unroll
    for (int r = 0; r < 16; ++r)
#pragma unroll
      for (int d0 = 0; d0 < 4; ++d0) { lds_f32* p = &X[crow(r, hie) * XS + d0 * 32 + r32e]; *p = o[d0][r] * rli[r] - *p; }
    asm volatile("s_waitcnt lgkmcnt(0)" ::: "memory");
    const int row = lane_e >> 1, hf = lane_e & 1;
    f32x4 v[16]; float ss = 0.f;
#pragma unroll
    for (int i = 0; i < 16; ++i) { v[i] = *(const __attribute__((address_space(3))) f32x4*)&X[row * XS + hf * 64 + i * 4]; ss += (v[i][0] * v[i][0] + v[i][1] * v[i][1]) + (v[i][2] * v[i][2] + v[i][3] * v[i][3]); }
    ss += __shfl_xor(ss, 1);
    const float rs = 0.8f / sqrtf(ss * (1.f / 128.f) + EPS);
    unsigned short* dst = YC + (size_t)(tok0 + qw0 + row) * 1536 + 1024 + h * 128 + hf * 64;
#pragma unroll
    for (int i = 0; i < 8; ++i) { const f32x4 g0 = *(const f32x4*)(subln_g + hf * 64 + i * 8), g1 = *(const f32x4*)(subln_g + hf * 64 + i * 8 + 4);
      const f32x4 a = v[2 * i] * g0 * rs, c = v[2 * i + 1] * g1 * rs;
      u32x4 w = {cvtpk(a[0], a[1]), cvtpk(a[2], a[3]), cvtpk(c[0], c[1]), cvtpk(c[2], c[3])}; *(u32x4*)(dst + i * 8) = w; }
  }
  asm volatile("s_waitcnt vmcnt(0) lgkmcnt(0)\n\ts_barrier" ::: "memory");
  return true;
#undef DMA_K
#undef DMA_V
#undef KIND
#undef KLOAD8
#undef NEARFIX
#undef RESCALE
#undef ROT
#undef PKW
#undef PAF
#undef VFR
#undef WFR
#undef PIN
#undef MF
#undef EX
#undef GAPA
#undef GAPB
#undef VRD
#undef WRD
#undef KRD
#undef STEP
#undef ENDW
}
#undef WAIT_BAR
#undef SBAR
}

constexpr int NWAVES = 8;
constexpr size_t MiB = 1u << 20;
constexpr size_t WS_CTL = 0, CTL_ZERO_BYTES = 64 * 1024;
constexpr size_t WS_G = 1 * MiB;
constexpr size_t WS_U2048 = 1 * MiB + 768 * 1024;
constexpr size_t WS_KN2B = 26 * MiB + 512 * 1024;
constexpr size_t WS_WQKV = 2 * MiB;
constexpr size_t WS_WF = 5 * MiB;
constexpr size_t WS_WO = 7 * MiB;
constexpr size_t WS_WUP = 10 * MiB;
constexpr size_t WS_WD = 21 * MiB;
constexpr size_t WS_XN = 27 * MiB;
constexpr int XN_ROWS = 1 + M + 129;
constexpr size_t WS_Q = 60 * MiB, WS_K = 76 * MiB, WS_V = 92 * MiB;
constexpr size_t WS_HE = 108 * MiB;
constexpr size_t WS_EO = 140 * MiB;
constexpr size_t WS_DM = 156 * MiB;
constexpr size_t WS_YC = 172 * MiB;
constexpr size_t WS_ACT = 60 * MiB;
constexpr size_t WS_END = 220 * MiB;
static_assert(WS_XN + (size_t)XN_ROWS * 2048 <= WS_Q && WS_ACT + (size_t)M * DFF * 2 <= WS_DM && WS_YC + (size_t)M * 1536 * 2 <= WS_END, "ws map");
constexpr int CW_TMO = 0, CW_BAR = 4096;

constexpr int RING_OFF = 0, RING_BYTES = 131072;
constexpr int XCH_OFF = RING_BYTES;
constexpr int LDSCTL_OFF = 147456, MISC_OFF = LDSCTL_OFF + 320;
constexpr int LDS_BYTES = LDSCTL_OFF + 1024;
static_assert(att::LDS_BYTES <= LDSCTL_OFF && XCH_OFF + 8192 <= LDSCTL_OFF, "LDS map");

#define GAS __attribute__((address_space(1)))
#define LAS __attribute__((address_space(3)))
typedef unsigned short bf16;
typedef unsigned v4u __attribute__((ext_vector_type(4)));
typedef float f32x4 __attribute__((ext_vector_type(4)));
typedef GAS unsigned gu32;
#define RLX_AGENT __ATOMIC_RELAXED, __HIP_MEMORY_SCOPE_AGENT
#define LDS_WAIT() asm volatile("s_waitcnt lgkmcnt(0)" ::: "memory")
#define VM_WAIT() asm volatile("s_waitcnt vmcnt(0)" ::: "memory")
__device__ __forceinline__ unsigned f2bf(float f) { unsigned u = __builtin_bit_cast(unsigned, f); return (u + 0x7fffu + ((u >> 16) & 1u)) >> 16; }
__device__ __forceinline__ unsigned pk2(float lo, float hi) { return f2bf(lo) | (f2bf(hi) << 16); }

#define XB_TMO      128
#define XB_XCNT(j)  (256  + 64 * (j))
#define XB_XSUB(j)  (1280 + 64 * (j))
#define XB_XGEN(j)  (2304 + 64 * (j))
#define XB_TOP      3328
#define XB_TOPGEN   3392
#define XCD_BAR_WORDS 3456
#define XB_SPIN_CAP (1u << 22)
__device__ __forceinline__ unsigned xb_ld(unsigned* p)              { return __hip_atomic_load(p, __ATOMIC_RELAXED, __HIP_MEMORY_SCOPE_AGENT); }
__device__ __forceinline__ unsigned xb_add(unsigned* p, unsigned v) { return __hip_atomic_fetch_add(p, v, __ATOMIC_RELAXED, __HIP_MEMORY_SCOPE_AGENT); }
__device__ __forceinline__ unsigned xb_xcc_id() { return (unsigned)__builtin_amdgcn_s_getreg((3 << 11) | 20) & 0xFu; }
#define XB_SPIN(cond, bar) do { unsigned _sp = 0; while (cond) { __builtin_amdgcn_s_sleep(1); \
    if ((++_sp & 255u) == 0u) { if (xb_ld(&(bar)[XB_TMO])) break; if (_sp > XB_SPIN_CAP) { atomicAdd(&(bar)[XB_TMO], 1u); break; } } } } while (0)
struct XcdBarrier { unsigned* bar; unsigned x; volatile LAS unsigned* st; };
__device__ __forceinline__ XcdBarrier xcd_barrier_post(unsigned* bar, volatile LAS unsigned* st) {
    XcdBarrier b; b.bar = bar; b.x = xb_xcc_id(); b.st = st;
    if (threadIdx.x == 0) (void)xb_add(&bar[XB_XCNT(b.x)], 1u);
    return b;
}
__device__ __forceinline__ void xcd_barrier_complete(unsigned* bar, unsigned x, unsigned& nloc, unsigned& nx) {
    const unsigned G = gridDim.x * gridDim.y * gridDim.z;
    unsigned sum, cnt, mine, sp = 0u;
    for (;;) {
        sum = 0u; cnt = 0u; mine = 0u;
#pragma unroll
        for (unsigned j = 0; j < 16; ++j) { const unsigned c = xb_ld(&bar[XB_XCNT(j)]); sum += c; cnt += (c > 0u) ? 1u : 0u; mine = (j == x) ? c : mine; }
        if (sum == G) break;
        __builtin_amdgcn_s_sleep(1);
        if ((++sp & 255u) == 0u) { if (xb_ld(&bar[XB_TMO])) break; if (sp > XB_SPIN_CAP) { atomicAdd(&bar[XB_TMO], 1u); break; } }
    }
    nloc = mine > 0u ? mine : 1u; nx = cnt > 0u ? cnt : 1u;
}
__device__ __forceinline__ void xcd_barrier(const XcdBarrier& b) {
    asm volatile("s_waitcnt vmcnt(0)" ::: "memory");
    __syncthreads();
    if (threadIdx.x == 0) {
        unsigned* bar = b.bar;
        __builtin_amdgcn_s_waitcnt(0);
        unsigned nloc = b.st[0], nx = b.st[1];
        if (nloc == 0u) { xcd_barrier_complete(bar, b.x, nloc, nx); b.st[0] = nloc; b.st[1] = nx; }
        const unsigned old = xb_add(&bar[XB_XSUB(b.x)], 1u);
        const unsigned gen = old / nloc;
        if (old + 1u == (gen + 1u) * nloc) {
            __builtin_amdgcn_fence(__ATOMIC_RELEASE, "agent");
            asm volatile("s_waitcnt vmcnt(0)" ::: "memory");
            const unsigned og = xb_add(&bar[XB_TOP], 1u);
            const unsigned tg = og / nx;
            if (og + 1u == (tg + 1u) * nx) xb_add(&bar[XB_TOPGEN], 1u);
            else XB_SPIN(xb_ld(&bar[XB_TOPGEN]) == tg, bar);
            __builtin_amdgcn_fence(__ATOMIC_ACQUIRE, "agent");
            xb_add(&bar[XB_XGEN(b.x)], 1u);
            asm volatile("s_waitcnt vmcnt(0)" ::: "memory");
        } else {
            XB_SPIN(xb_ld(&bar[XB_XGEN(b.x)]) == gen, bar);
            __builtin_amdgcn_fence(__ATOMIC_ACQUIRE, "agent");
            asm volatile("s_waitcnt vmcnt(0)" ::: "memory");
        }
    }
    __syncthreads();
}

struct Frame {
    LAS unsigned char* lds;
    volatile LAS unsigned* MISC;
    gu32* ctl;
    int tid, lane, wave, vcu, G;
};
__device__ __forceinline__ float wave_sum(float v) {
#pragma unroll
    for (int o = 1; o < 64; o <<= 1) v += __shfl_xor(v, o);
    return v;
}
__device__ __forceinline__ void p0_transpose_item(const float* W, int ldw, bf16* WT, int ldt, LAS float* scr, int kb, int nb, int lane) {
    const int k0 = 64 * kb, n0 = 32 * nb;
#pragma unroll 8
    for (int i = 0; i < 32; ++i) { const int kk = 2 * i + (lane >> 5); scr[kk * 33 + (lane & 31)] = W[(size_t)(k0 + kk) * ldw + n0 + (lane & 31)]; }
    LDS_WAIT(); asm volatile("" ::: "memory");
    const int c = lane & 7;
#pragma unroll
    for (int j = 0; j < 4; ++j) { const int n = (lane >> 3) + 8 * j; const LAS float* s = scr + (8 * c) * 33 + n;
        v4u o; o.x = pk2(s[0 * 33], s[1 * 33]); o.y = pk2(s[2 * 33], s[3 * 33]); o.z = pk2(s[4 * 33], s[5 * 33]); o.w = pk2(s[6 * 33], s[7 * 33]);
        *(GAS v4u*)(WT + (size_t)(n0 + n) * ldt + k0 + 8 * c) = o; }
    LDS_WAIT(); asm volatile("" ::: "memory");
}
__device__ __forceinline__ void rms_row_to_bf16(int lane, const float* xrow, const float* g, bf16* orow) {
    const GAS f32x4* xr = (const GAS f32x4*)xrow + lane; const GAS f32x4* gr = (const GAS f32x4*)g + lane;
    f32x4 v[4]; float s = 0.f;
#pragma unroll
    for (int j = 0; j < 4; ++j) { v[j] = xr[64 * j]; s += (v[j].x * v[j].x + v[j].y * v[j].y) + (v[j].z * v[j].z + v[j].w * v[j].w); }
    const float rstd = 1.f / sqrtf(wave_sum(s) * (1.f / D) + EPS);
    GAS unsigned long long* o8 = (GAS unsigned long long*)orow + lane;
#pragma unroll
    for (int j = 0; j < 4; ++j) { const f32x4 gg = gr[64 * j];
        o8[64 * j] = (unsigned long long)pk2(v[j].x * rstd * gg.x, v[j].y * rstd * gg.y) | ((unsigned long long)pk2(v[j].z * rstd * gg.z, v[j].w * rstd * gg.w) << 32); }
}
__device__ __forceinline__ void rms_row_f32(int lane, const float* xrow, const float* g, float* orow) {
    const GAS f32x4* xr = (const GAS f32x4*)xrow + lane; const GAS f32x4* gr = (const GAS f32x4*)g + lane;
    f32x4 v[4]; float s = 0.f;
#pragma unroll
    for (int j = 0; j < 4; ++j) { v[j] = xr[64 * j]; s += (v[j].x * v[j].x + v[j].y * v[j].y) + (v[j].z * v[j].z + v[j].w * v[j].w); }
    const float rstd = 1.f / sqrtf(wave_sum(s) * (1.f / D) + EPS);
    GAS f32x4* o = (GAS f32x4*)orow + lane;
#pragma unroll
    for (int j = 0; j < 4; ++j) o[64 * j] = v[j] * rstd * gr[64 * j];
}

struct Args { const float* in[18]; float* out; unsigned char* ws; int ph_lo, ph_hi, li, pad; };

__global__ void __launch_bounds__(NWAVES * 64, 2) enc_fwd(Args args) {
    extern __shared__ __attribute__((aligned(16))) unsigned char lds[];
    Frame F;
    F.lds = (LAS unsigned char*)lds;
    F.MISC = (volatile LAS unsigned*)(F.lds + MISC_OFF);
    F.tid = threadIdx.x; F.lane = F.tid & 63; F.wave = __builtin_amdgcn_readfirstlane(F.tid >> 6);
    F.G = gridDim.x; { const int bx = blockIdx.x; F.vcu = (F.G % 8 == 0) ? (bx % 8) * (F.G / 8) + bx / 8 : bx; }
    unsigned char* ws = args.ws;
    F.ctl = (gu32*)(ws + WS_CTL);
    const float* x = args.in[0]; const float* norm_mix_g = args.in[1]; const float* w_in = args.in[2]; const float* fourier_w = args.in[3]; const float* fourier_b = args.in[4];
    const float* lq1 = args.in[5]; const float* lk1 = args.in[6]; const float* lq2 = args.in[7]; const float* lk2 = args.in[8]; const float* subln_g = args.in[9];
    const float* rel_bias = args.in[10]; const float* w_out = args.in[11]; const float* norm_ffn_g = args.in[12]; const float* w_up = args.in[13];
    const float* conv_w = args.in[14]; const float* conv_b = args.in[15]; const float* w_down = args.in[16]; const float* norm_final_g = args.in[17];
    float* out = args.out;
    float* Gt = (float*)(ws + WS_G); float* U2048 = (float*)(ws + WS_U2048); float* knorm2 = (float*)(ws + WS_KN2B);
    bf16* Wqkv_t = (bf16*)(ws + WS_WQKV); bf16* Wf_t = (bf16*)(ws + WS_WF); bf16* Wo_t = (bf16*)(ws + WS_WO); bf16* Wup_t = (bf16*)(ws + WS_WUP); bf16* Wd_t = (bf16*)(ws + WS_WD);
    bf16* XN = (bf16*)(ws + WS_XN); bf16* Qb = (bf16*)(ws + WS_Q); bf16* Kb = (bf16*)(ws + WS_K); bf16* Vb = (bf16*)(ws + WS_V);
    bf16* HE = (bf16*)(ws + WS_HE); bf16* EO = (bf16*)(ws + WS_EO); bf16* DM = (bf16*)(ws + WS_DM); bf16* YC = (bf16*)(ws + WS_YC); bf16* ACT = (bf16*)(ws + WS_ACT);

    for (int u = F.tid; u < (LDS_BYTES - LDSCTL_OFF) / 4; u += NWAVES * 64) ((LAS unsigned*)(F.lds + LDSCTL_OFF))[u] = 0u;
    __syncthreads();
    XcdBarrier bar; bar.bar = (unsigned*)(F.ctl + CW_BAR); bar.x = 0; bar.st = nullptr;
    if (MK_N_LAUNCHES == 1) bar = xcd_barrier_post((unsigned*)(F.ctl + CW_BAR), F.MISC + 8);
#define GRID_BAR() do { if (MK_N_LAUNCHES == 1) xcd_barrier(bar); } while (0)
    const int lo = args.ph_lo, hi = args.ph_hi;
#ifndef PH_MASK
#define PH_MASK 0x3ff
#endif
#define IN(k) (((PH_MASK >> (k)) & 1) && lo <= (k) && (k) < hi)
#define BOTH(k) (IN(k) && IN((k) + 1))
#ifndef PROBE_DUP
#define PROBE_DUP -1
#endif
#define REP(k) for (int rep_ = 0; rep_ < ((PROBE_DUP == (k)) ? 2 : 1); ++rep_)
    const int gw = F.vcu * NWAVES + F.wave, NGW = F.G * NWAVES;
    const int gt = blockIdx.x * (NWAVES * 64) + F.tid, NGT = F.G * NWAVES * 64;

    if (IN(0)) { REP(0) {
        { LAS float* ct = (LAS float*)(F.lds + RING_OFF);
          __syncthreads();
          if (F.tid < 128) ct[F.tid] = cospif((float)F.tid * (1.f / 64.f));
          __syncthreads();
          for (int idx = gt; idx < 2 * 4 * 128 * 128; idx += NGT) {
              const int d = idx & 127, c = (idx >> 7) & 127, g = (idx >> 14) & 3, part = idx >> 16;
              const float* wg = fourier_w + (size_t)g * 16384 + d; float s = 0.f;
              for (int cp = 0; cp < 128; ++cp) { const int mm = (c * cp) & 127; const float t = part == 0 ? ct[mm] : ct[(mm - 32) & 127]; s += t * wg[cp * 128]; }
              Gt[idx] = s * 0.08838834764831845f;
          }
          __syncthreads(); }
        for (int idx = gt; idx < M * 8; idx += NGT) knorm2[idx] = 0.f;
        { LAS float* scr = (LAS float*)(F.lds + RING_OFF + F.wave * 16384);
          constexpr int I_QKV = 16 * 48, I_O = 3 * 8 * 32, I_UP = 16 * 176, I_D = 44 * 32, NITEMS = I_QKV + I_O + I_UP + I_D;
          for (int it = gw; it < NITEMS; it += NGW) {
              int r = it;
              if (r < I_QKV) { p0_transpose_item(w_in + 512, 2048, Wqkv_t, 1024, scr, r / 48, r % 48, F.lane); continue; } r -= I_QKV;
              if (r < I_O) { const int blk = r / 256, q = r % 256;
                  p0_transpose_item(w_out + (size_t)(blk == 2 ? 512 : 0) * 1024, 1024, Wo_t + blk * 512, 1536, scr, q / 32, q % 32, F.lane); continue; } r -= I_O;
              if (r < I_UP) { p0_transpose_item(w_up, NUP, Wup_t, 1024, scr, r / 176, r % 176, F.lane); continue; } r -= I_UP;
              p0_transpose_item(w_down, 1024, Wd_t, DFF, scr, r / 32, r % 32, F.lane);
          } }
        for (int it = gw; it < 4 * 2048; it += NGW) {
            const int b = it >> 11, s = it & 2047; const int r1 = b * SEQ + s, r2 = b * SEQ + (s == 0 ? 2048 : SEQ - s);
            const GAS f32x4* x1 = (const GAS f32x4*)(x + (size_t)r1 * D) + F.lane; const GAS f32x4* x2 = (const GAS f32x4*)(x + (size_t)r2 * D) + F.lane;
            const GAS f32x4* gr = (const GAS f32x4*)norm_mix_g + F.lane;
            f32x4 v1[4], v2[4]; float s1 = 0.f, s2 = 0.f;
#pragma unroll
            for (int j = 0; j < 4; ++j) { v1[j] = x1[64 * j]; v2[j] = x2[64 * j];
                s1 += (v1[j].x * v1[j].x + v1[j].y * v1[j].y) + (v1[j].z * v1[j].z + v1[j].w * v1[j].w); s2 += (v2[j].x * v2[j].x + v2[j].y * v2[j].y) + (v2[j].z * v2[j].z + v2[j].w * v2[j].w); }
            const float rs1 = 1.f / sqrtf(wave_sum(s1) * (1.f / D) + EPS), rs2 = 1.f / sqrtf(wave_sum(s2) * (1.f / D) + EPS);
            GAS unsigned long long* o1 = (GAS unsigned long long*)(XN + (size_t)(r1 + 1) * D) + F.lane; GAS unsigned long long* o2 = (GAS unsigned long long*)(XN + (size_t)(r2 + 1) * D) + F.lane;
            GAS unsigned long long* oe = (GAS unsigned long long*)(HE + (size_t)(b * 2048 + s) * D) + F.lane; GAS unsigned long long* oo = (GAS unsigned long long*)(HE + (size_t)(8192 + b * 2048 + s) * D) + F.lane;
#pragma unroll
            for (int j = 0; j < 4; ++j) { const f32x4 gg = gr[64 * j]; const f32x4 a = v1[j] * rs1 * gg, c = v2[j] * rs2 * gg;
                o1[64 * j] = (unsigned long long)pk2(a.x, a.y) | ((unsigned long long)pk2(a.z, a.w) << 32);
                o2[64 * j] = (unsigned long long)pk2(c.x, c.y) | ((unsigned long long)pk2(c.z, c.w) << 32);
                const f32x4 e = (s == 0) ? a : a + c, o = (s == 0) ? (f32x4){0.f, 0.f, 0.f, 0.f} : a - c;
                oe[64 * j] = (unsigned long long)pk2(e.x, e.y) | ((unsigned long long)pk2(e.z, e.w) << 32);
                oo[64 * j] = (unsigned long long)pk2(o.x, o.y) | ((unsigned long long)pk2(o.z, o.w) << 32); }
        }
        for (int idx = gt; idx < 130 * 128; idx += NGT) { const int r = idx >> 7, c = idx & 127; const int row = (r == 0) ? 0 : (M + r);
            *(GAS v4u*)(XN + (size_t)row * D + c * 8) = (v4u){0u, 0u, 0u, 0u}; }
        { __syncthreads();
          LAS float* ct = (LAS float*)(F.lds + RING_OFF);
          for (int i = F.tid; i < 4096; i += NWAVES * 64) ct[i] = cospif((float)i * (1.f / 2048.f)) * (1.f / 64.f);
          __syncthreads();
          for (int idx = gt; idx < 2 * 2048 * 256; idx += NGT) {
              const int type = idx >> 19, sp = (idx >> 8) & 2047, s0 = (idx & 255) * 8;
              float v[8];
#pragma unroll
              for (int e = 0; e < 8; ++e) v[e] = ct[(sp * (s0 + e) - type * 1024) & 4095];
              *(GAS v4u*)(DM + (size_t)type * 2048 * 2048 + (size_t)sp * 2048 + s0) = (v4u){pk2(v[0], v[1]), pk2(v[2], v[3]), pk2(v[4], v[5]), pk2(v[6], v[7])};
          }
          __syncthreads(); } }
        if (BOTH(0)) GRID_BAR();
    }
    if (IN(1)) {
        LAS float* wl = (LAS float*)(F.lds + RING_OFF);
        for (int item = blockIdx.x; item < 128; item += F.G) {
            const int part = item >> 6, g = (item >> 4) & 3, kb = item & 15;
            __syncthreads();
            for (int i = F.tid; i < 64 * 32; i += NWAVES * 64) { const int kk = i >> 5, c4 = (i & 31) * 4;
                *(LAS f32x4*)(wl + kk * 128 + c4) = *(const f32x4*)(w_in + (size_t)(kb * 64 + kk) * 2048 + g * 128 + c4); }
            __syncthreads();
            const int d = F.tid & 127, kq = F.tid >> 7;
            const float* Gp = Gt + (size_t)(part * 4 + g) * 16384 + d;
            float acc[16];
#pragma unroll
            for (int j = 0; j < 16; ++j) acc[j] = 0.f;
            for (int c4 = 0; c4 < 128; c4 += 4) {
                const float g0 = Gp[(c4 + 0) * 128], g1 = Gp[(c4 + 1) * 128], g2 = Gp[(c4 + 2) * 128], g3 = Gp[(c4 + 3) * 128];
#pragma unroll
                for (int j = 0; j < 16; ++j) { const f32x4 w = *(const LAS f32x4*)(wl + (kq * 16 + j) * 128 + c4); acc[j] += (w.x * g0 + w.y * g1) + (w.z * g2 + w.w * g3); }
            }
            bf16* dst = Wf_t + (size_t)(part * 512 + g * 128 + d) * 1024 + kb * 64 + kq * 16;
            *(GAS v4u*)(dst) = (v4u){pk2(acc[0], acc[1]), pk2(acc[2], acc[3]), pk2(acc[4], acc[5]), pk2(acc[6], acc[7])};
            *(GAS v4u*)(dst + 8) = (v4u){pk2(acc[8], acc[9]), pk2(acc[10], acc[11]), pk2(acc[12], acc[13]), pk2(acc[14], acc[15])};
        }
        __syncthreads();
        if (BOTH(1)) GRID_BAR();
    }
    if (IN(2)) {
        { pg8::Gemm g{XN + D, Wqkv_t, D, (size_t)256 * D * 2, (size_t)128 * D * 2, (size_t)256 * D * 2, (size_t)128 * D * 2, 0, 0};
          pg8::StaticOrder S; S.init(M / 256, 1536 / 256, F.G, (int)blockIdx.x);
          pg8::EpiQKV E{Qb, (size_t)(WS_K - WS_Q) / 2, 0.125f * LOG2E, knorm2};
          pg8::gemm_phase<pg8::EpiQKV, pg8::StaticOrder>(F.lds + RING_OFF, g, S, E); }
        {
          pg8::Gemm g{Wf_t, HE, D, (size_t)256 * D * 2, (size_t)128 * D * 2, (size_t)256 * D * 2, (size_t)128 * D * 2, 1, (size_t)8192 * D * 2};
          pg8::StaticOrder S; S.init(4, 32, F.G, (int)blockIdx.x);
          pg8::EpiEO E{EO};
          pg8::gemm_phase<pg8::EpiEO, pg8::StaticOrder>(F.lds + RING_OFF, g, S, E); }
        for (int it = gw; it < 4 * 512; it += NGW) { const int b = it >> 9, d = it & 511;
            const v4u wa = *(const GAS v4u*)(Wf_t + (size_t)d * D + F.lane * 16), wb = *(const GAS v4u*)(Wf_t + (size_t)d * D + F.lane * 16 + 8);
            const v4u xa = *(const GAS v4u*)(XN + (size_t)(b * SEQ + 2048 + 1) * D + F.lane * 16), xb = *(const GAS v4u*)(XN + (size_t)(b * SEQ + 2048 + 1) * D + F.lane * 16 + 8);
            float sacc = 0.f;
#pragma unroll
            for (int e = 0; e < 4; ++e) { sacc += __uint_as_float(wa[e] << 16) * __uint_as_float(xa[e] << 16) + __uint_as_float(wa[e] & 0xffff0000u) * __uint_as_float(xa[e] & 0xffff0000u);
                                          sacc += __uint_as_float(wb[e] << 16) * __uint_as_float(xb[e] << 16) + __uint_as_float(wb[e] & 0xffff0000u) * __uint_as_float(xb[e] & 0xffff0000u); }
            sacc = wave_sum(sacc);
            if (F.lane == 0) U2048[it] = sacc * (1.f / 64.f); }
        if (BOTH(2)) GRID_BAR();
    }
    if (IN(3)) {
        for (int it = gw; it < 4 * 512; it += NGW) { const int b = it >> 9, d = it & 511; const bf16* er = EO + (size_t)it * 2048 + F.lane * 8;
            float sacc = 0.f;
#pragma unroll
            for (int i = 0; i < 4; ++i) { const v4u w = *(const GAS v4u*)(er + i * 512);
#pragma unroll
                for (int e = 0; e < 4; ++e) sacc += __uint_as_float(w[e] << 16) - __uint_as_float(w[e] & 0xffff0000u); }
            sacc = wave_sum(sacc);
            if (F.lane == 0) { YC[(size_t)(b * SEQ + 2048) * 1536 + d] = (bf16)f2bf(sacc * (1.f / 64.f) + U2048[it] + fourier_b[d]); YC[(size_t)(b * SEQ + 2048) * 1536 + 512 + d] = 0; } }
        REP(4) { const int di = F.vcu >> 1;
          pg8::Gemm g{DM, EO, 2048, (size_t)256 * 2048 * 2, (size_t)128 * 2048 * 2, (size_t)256 * 2048 * 2, (size_t)128 * 2048 * 2, 3, (size_t)2048 * 2048 * 2};
          pg8::OneUnit S{di >> 3, di & 7, (F.vcu & 1) == 0 && di < 128};
          pg8::EpiDFT E{YC, fourier_b, U2048};
          pg8::gemm_phase<pg8::EpiDFT, pg8::OneUnit>(F.lds + RING_OFF, g, S, E); }
        float lam;
        { const float a = lq1[F.lane] * lk1[F.lane], c = lq2[F.lane] * lk2[F.lane]; lam = expf(wave_sum(a)) - expf(wave_sum(c)) + 0.2f; lam = __uint_as_float(__builtin_amdgcn_readfirstlane(__float_as_uint(lam))); }
        REP(3) for (int uix = F.vcu; uix < 512; uix += F.G) {
            const int grp = uix / 32, qblk = uix % 32; const int b = grp >> 2, h = grp & 3;
            if (!att::attn_unit_v3(b, h, qblk, (const att::bf16*)Qb, (const att::bf16*)Kb, (const att::bf16*)Vb, YC, rel_bias, subln_g, knorm2, lam, F.lds))
                att::attn_unit(b, h, qblk, (const att::bf16*)Qb, (const att::bf16*)Kb, (const att::bf16*)Vb, YC, rel_bias, subln_g, lam, (char*)lds);
        }
        if (IN(3) && IN(5)) GRID_BAR();
    }
    if (IN(5)) {
        pg8::Gemm g{YC, Wo_t, 1536, (size_t)256 * 1536 * 2, (size_t)128 * 1536 * 2, (size_t)256 * 1536 * 2, (size_t)128 * 1536 * 2, 0, 0};
        pg8::StaticOrder S; S.init(M / 256, D / 256, F.G, (int)blockIdx.x);
        pg8::EpiResF32 E{x, out};
        pg8::gemm_phase<pg8::EpiResF32, pg8::StaticOrder>(F.lds + RING_OFF, g, S, E);
        if (BOTH(5)) GRID_BAR();
    }
    if (IN(6)) {
        for (int m = gw; m < M; m += NGW) rms_row_to_bf16(F.lane, out + (size_t)m * D, norm_ffn_g, XN + (size_t)(m + 1) * D);
        if (BOTH(6)) GRID_BAR();
    }
    if (IN(7)) {
        pg8::Gemm g{XN, Wup_t, D, (size_t)254 * D * 2, (size_t)128 * D * 2, (size_t)128 * D * 2, (size_t)DFF * D * 2, 0, 0};
        pg8::StaticOrder S; S.init(65, 22, F.G, (int)blockIdx.x);
        pg8::EpiConvAct E{ACT, conv_w, conv_b, (LAS float*)(F.lds + XCH_OFF)};
        REP(7) pg8::gemm_phase<pg8::EpiConvAct, pg8::StaticOrder>(F.lds + RING_OFF, g, S, E);
        if (BOTH(7)) GRID_BAR();
    }
    if (IN(8)) {
        pg8::Gemm g{ACT, Wd_t, DFF, (size_t)256 * DFF * 2, (size_t)128 * DFF * 2, (size_t)256 * DFF * 2, (size_t)128 * DFF * 2, 0, 0};
        pg8::StaticOrder S; S.init(M / 256, D / 256, F.G, (int)blockIdx.x);
        pg8::EpiResF32 E{out, out};
        pg8::gemm_phase<pg8::EpiResF32, pg8::StaticOrder>(F.lds + RING_OFF, g, S, E);
        if (BOTH(8)) GRID_BAR();
    }
    if (IN(9)) {
        for (int m = gw; m < M; m += NGW) rms_row_f32(F.lane, out + (size_t)m * D, norm_final_g, out + (size_t)m * D);
    }
#undef IN
#undef BOTH
}

extern "C" void kernel_launch(void* const* d_in, const int* in_sizes, int n_in, void* d_out, int out_size, void* d_ws, size_t ws_size, hipStream_t stream) {
    static int grid = 0;
    if (grid == 0) {
        if (n_in != 18 || in_sizes[0] != M * D || out_size != M * D || ws_size < WS_END) { fprintf(stderr, "kernel_launch: unexpected shapes (n_in %d, in0 %d, out %d, ws %zu)\n", n_in, n_in > 0 ? in_sizes[0] : -1, out_size, ws_size); grid = -1; return; }
        int dev = 0, cus = 0, per_cu = 0;
        if (hipGetDevice(&dev) != hipSuccess || hipDeviceGetAttribute(&cus, hipDeviceAttributeMultiprocessorCount, dev) != hipSuccess) { grid = -1; return; }
        if (hipFuncSetAttribute((const void*)enc_fwd, hipFuncAttributeMaxDynamicSharedMemorySize, LDS_BYTES) != hipSuccess) { fprintf(stderr, "kernel_launch: hipFuncSetAttribute failed\n"); grid = -1; return; }
        if (hipOccupancyMaxActiveBlocksPerMultiprocessor(&per_cu, (const void*)enc_fwd, NWAVES * 64, LDS_BYTES) != hipSuccess || per_cu < 1) { fprintf(stderr, "kernel_launch: occupancy query says %d blocks per CU\n", per_cu); }
        (void)hipGetLastError();
        grid = cus;
    }
    if (grid < 0) return;
    (void)hipMemsetAsync((char*)d_ws + WS_CTL, 0, CTL_ZERO_BYTES, stream);
    Args a{};
    for (int i = 0; i < 18; ++i) a.in[i] = (const float*)d_in[i];
    a.out = (float*)d_out; a.ws = (unsigned char*)d_ws;
    if (MK_N_LAUNCHES == 1) {
        a.ph_lo = 0; a.ph_hi = N_PHASES; a.li = 0;
        hipLaunchKernelGGL(enc_fwd, dim3(grid), dim3(NWAVES * 64), LDS_BYTES, stream, a);
    } else {
        for (int li = 0; li < N_PHASES; ++li) { a.ph_lo = li; a.ph_hi = li + 1; a.li = li;
            hipLaunchKernelGGL(enc_fwd, dim3(grid), dim3(NWAVES * 64), LDS_BYTES, stream, a); }
    }
}
```
